# Optimizing an MI355X kernel written in HIP

```python
import math
import jax, jax.numpy as jnp
from jax import lax
import numpy as np

D_MODEL = 1024
BATCH = 8
SEQ = 2048
DEPTH = 2

D_PLE = 256
EPS = 1e-6
ATT_HEADS = 8
ATT_HD = 64
ATT_VD = 2 * ATT_HD
ATT_W = ATT_HEADS * ATT_VD
Q_BLOCK = 128
DN_HEADS = 4
DN_HD = 128
DN_W = DN_HEADS * DN_HD
DN_CONV = 4
DN_CHUNK = 64
GLA_HEADS = 4
GLA_KD = 64
GLA_VD = 128
GLA_KW = GLA_HEADS * GLA_KD
GLA_W = GLA_HEADS * GLA_VD
GLA_RANK = 16
GLA_TAU = 16.0
GLA_CHUNK = 64
D_MIX = ATT_W + DN_W + GLA_W

IN_SPLITS = (ATT_W, ATT_W, ATT_W, ATT_W,
             DN_W, DN_W, DN_W, DN_W,
             DN_HEADS, DN_HEADS,
             GLA_KW, GLA_KW, GLA_W, GLA_W,
             GLA_RANK)
D_IN = sum(IN_SPLITS)
SPLIT_IDX = tuple(int(i) for i in np.cumsum(IN_SPLITS)[:-1])

kernel_name = "hybrid_diffattn_gdn_gla_parallel"


def rmsnorm(x, g):
    xf = x.astype(jnp.float32)
    y = xf * lax.rsqrt(jnp.mean(xf * xf, axis=-1, keepdims=True) + EPS)
    return (y * g.astype(jnp.float32)).astype(x.dtype)


def l2norm(x):
    xf = x.astype(jnp.float32)
    return xf * lax.rsqrt(jnp.sum(xf * xf, axis=-1, keepdims=True) + EPS)


def heads(x, n):
    b, s, w = x.shape
    return x.reshape(b, s, n, w // n).transpose(0, 2, 1, 3)


def merge(x):
    b, n, s, d = x.shape
    return x.transpose(0, 2, 1, 3).reshape(b, s, n * d)


def alibi_slopes(n):
    return 2.0 ** (-8.0 * jnp.arange(1, n + 1, dtype=jnp.float32) / n)


def causal_conv(x, w):
    k, c = w.shape
    return lax.conv_general_dilated(
        x, w[:, None, :].astype(x.dtype), window_strides=(1,), padding=[(k - 1, 0)],
        dimension_numbers=('NWC', 'WIO', 'NWC'), feature_group_count=c)


def diff_attention(q, k, v, lam):
    s = q.shape[3]
    scale = ATT_HD ** -0.5
    slopes = alibi_slopes(ATT_HEADS)[:, None, None, None]
    kf = k.astype(jnp.float32)
    vf = v.astype(jnp.float32)
    outs = []
    for start in range(0, s, Q_BLOCK):
        end = min(start + Q_BLOCK, s)
        qb = q[:, :, :, start:end].astype(jnp.float32)
        sc = jnp.einsum('bhmqd,bhmkd->bhmqk', qb, kf[:, :, :, :end]) * scale
        dist = (jnp.arange(start, end)[:, None] - jnp.arange(end)[None, :]).astype(jnp.float32)
        sc = jnp.where(dist >= 0, sc - slopes * dist, -jnp.inf)
        pr = jax.nn.softmax(sc, axis=-1)
        a = pr[:, :, 0] - lam * pr[:, :, 1]
        outs.append(jnp.einsum('bhqk,bhkd->bhqd', a, vf[:, :, :end]))
    return jnp.concatenate(outs, axis=2)


def gated_delta_rule(q, k, v, beta, g):
    b, h, s, dk = q.shape
    dv = v.shape[-1]
    c = DN_CHUNK
    n = s // c
    q = q * dk ** -0.5
    rs = lambda t: t.reshape(b, h, n, c, *t.shape[3:])
    q, k, v, beta, g = rs(q), rs(k), rs(v), rs(beta), rs(g)
    gc = jnp.cumsum(g, axis=-1)
    tri_incl = jnp.tril(jnp.ones((c, c), bool))
    tri_strict = jnp.tril(jnp.ones((c, c), bool), -1)
    decay = jnp.exp(jnp.where(tri_incl, gc[..., :, None] - gc[..., None, :], -jnp.inf))
    kb = k * beta[..., None]
    m = jnp.where(tri_strict, jnp.einsum('bhnid,bhnjd->bhnij', kb, k) * decay, 0.0)
    eye = jnp.eye(c, dtype=jnp.float32)
    t_inv = lax.linalg.triangular_solve(eye + m, jnp.broadcast_to(eye, m.shape),
                                        left_side=True, lower=True, unit_diagonal=True)
    u = t_inv @ (v * beta[..., None])
    w = t_inv @ (kb * jnp.exp(gc)[..., None])
    a_intra = jnp.einsum('bhnid,bhnjd->bhnij', q, k) * decay
    g_last = gc[..., -1]
    k_dec = k * jnp.exp(g_last[..., None] - gc)[..., None]
    q_dec = q * jnp.exp(gc)[..., None]

    def step(state, xs):
        w_c, u_c, q_c, k_c, a_c, gl = xs
        v_new = u_c - jnp.einsum('bhcd,bhde->bhce', w_c, state)
        o = jnp.einsum('bhcd,bhde->bhce', q_c, state) + jnp.einsum('bhij,bhje->bhie', a_c, v_new)
        state = state * jnp.exp(gl)[..., None, None] + jnp.einsum('bhcd,bhce->bhde', k_c, v_new)
        return state, o

    xs = (jnp.moveaxis(w, 2, 0), jnp.moveaxis(u, 2, 0), jnp.moveaxis(q_dec, 2, 0),
          jnp.moveaxis(k_dec, 2, 0), jnp.moveaxis(a_intra, 2, 0), jnp.moveaxis(g_last, 2, 0))
    s0 = jnp.zeros((b, h, dk, dv), jnp.float32)
    _, o = lax.scan(step, s0, xs)
    return jnp.moveaxis(o, 0, 2).reshape(b, h, s, dv)


def gla_chunked(q, k, v, gk):
    b, h, s, dk = q.shape
    dv = v.shape[-1]
    c = GLA_CHUNK
    n = s // c
    q = q * dk ** -0.5
    rs = lambda t: jnp.moveaxis(t.reshape(b, h, n, c, t.shape[-1]), 2, 0)
    q, k, v, bc = rs(q), rs(k), rs(v), rs(gk)
    bc = jnp.cumsum(bc, axis=3)
    tri = jnp.tril(jnp.ones((c, c), bool))[..., None]

    def step(state, xs):
        q_c, k_c, v_c, b_c = xs
        inter = jnp.einsum('bhcd,bhde->bhce', q_c * jnp.exp(b_c), state)
        rel = jnp.exp(jnp.where(tri, b_c[:, :, :, None, :] - b_c[:, :, None, :, :], -jnp.inf))
        att = jnp.einsum('bhid,bhjd,bhijd->bhij', q_c, k_c, rel)
        o = inter + jnp.einsum('bhij,bhje->bhie', att, v_c)
        b_last = b_c[:, :, -1]
        state = state * jnp.exp(b_last)[..., None] + jnp.einsum(
            'bhcd,bhce->bhde', k_c * jnp.exp(b_last[:, :, None] - b_c), v_c)
        return state, o

    s0 = jnp.zeros((b, h, dk, dv), jnp.float32)
    _, o = lax.scan(step, s0, (q, k, v, bc))
    return jnp.moveaxis(o, 0, 2).reshape(b, h, s, dv)


def hybrid_layer(x, p_l, w_in, w_out, pre_g, post_g, lq1, lk1, lq2, lk2, att_subln,
                 dn_conv, dn_a_log, dn_dt_bias, dn_norm, gla_w2, gla_b, gla_norm,
                 ple_proj, ple_gate, ple_norm, layer_idx):
    dt = x.dtype
    bsz, s, _ = x.shape
    h = rmsnorm(x, pre_g)
    proj = h @ w_in
    (a_q, a_k, a_v, a_z, d_q, d_k, d_v, d_z, d_b, d_a,
     g_q, g_k, g_v, g_z, g_r) = jnp.split(proj, SPLIT_IDX, axis=-1)

    split2 = lambda t: t.reshape(bsz, s, ATT_HEADS, 2, ATT_HD).transpose(0, 2, 3, 1, 4)
    lam_init = 0.8 - 0.6 * math.exp(-0.3 * layer_idx)
    lam = (jnp.exp(jnp.sum(lq1.astype(jnp.float32) * lk1.astype(jnp.float32)))
           - jnp.exp(jnp.sum(lq2.astype(jnp.float32) * lk2.astype(jnp.float32))) + lam_init)
    o_att = diff_attention(split2(a_q), split2(a_k), heads(a_v, ATT_HEADS), lam)
    o_att = rmsnorm(o_att, att_subln) * (1.0 - lam_init)
    y_att = merge(o_att).astype(dt) * jax.nn.silu(a_z)

    qkv = jax.nn.silu(causal_conv(jnp.concatenate([d_q, d_k, d_v], axis=-1), dn_conv))
    c_q, c_k, c_v = jnp.split(qkv, 3, axis=-1)
    beta = jax.nn.sigmoid(d_b.astype(jnp.float32)).transpose(0, 2, 1)
    g = (-jnp.exp(dn_a_log.astype(jnp.float32))
         * jax.nn.softplus(d_a.astype(jnp.float32) + dn_dt_bias.astype(jnp.float32))).transpose(0, 2, 1)
    o_dn = gated_delta_rule(l2norm(heads(c_q, DN_HEADS)), l2norm(heads(c_k, DN_HEADS)),
                            heads(c_v, DN_HEADS).astype(jnp.float32), beta, g)
    y_dn = merge(rmsnorm(o_dn, dn_norm)).astype(dt) * jax.nn.silu(d_z)

    gk = jax.nn.log_sigmoid((g_r @ gla_w2 + gla_b).astype(jnp.float32)) / GLA_TAU
    o_gla = gla_chunked(heads(g_q, GLA_HEADS).astype(jnp.float32),
                        heads(g_k, GLA_HEADS).astype(jnp.float32),
                        heads(g_v, GLA_HEADS).astype(jnp.float32),
                        heads(gk, GLA_HEADS))
    y_gla = merge(rmsnorm(o_gla, gla_norm)).astype(dt) * jax.nn.silu(g_z)

    y = jnp.concatenate([y_att, y_dn, y_gla], axis=-1) @ w_out
    x = x + rmsnorm(y, post_g)

    gate = jax.nn.sigmoid(x @ ple_gate)
    x = x + rmsnorm((p_l @ ple_proj) * gate, ple_norm)
    return x


def setup_inputs(seed: int = 0) -> dict:
    key = jax.random.key(seed)
    ks = jax.random.split(key, 24)
    nrm = lambda k, shape, scale: jax.random.normal(k, shape, jnp.float32) * scale
    gain = lambda k, shape: 1.0 + 0.02 * jax.random.normal(k, shape, jnp.float32)
    dt_init = jnp.exp(jax.random.uniform(ks[13], (DEPTH, DN_HEADS), jnp.float32,
                                         math.log(1e-3), math.log(1e-1)))
    return {
        "x": nrm(ks[0], (BATCH, SEQ, D_MODEL), 1.0),
        "p": nrm(ks[1], (DEPTH, BATCH, SEQ, D_PLE), 1.0),
        "w_in": nrm(ks[2], (DEPTH, D_MODEL, D_IN), D_MODEL ** -0.5),
        "w_out": nrm(ks[3], (DEPTH, D_MIX, D_MODEL), D_MIX ** -0.5),
        "pre_gain": gain(ks[4], (DEPTH, D_MODEL)),
        "post_gain": gain(ks[5], (DEPTH, D_MODEL)),
        "att_lq1": nrm(ks[6], (DEPTH, ATT_HD), 0.1),
        "att_lk1": nrm(ks[7], (DEPTH, ATT_HD), 0.1),
        "att_lq2": nrm(ks[8], (DEPTH, ATT_HD), 0.1),
        "att_lk2": nrm(ks[9], (DEPTH, ATT_HD), 0.1),
        "att_subln": gain(ks[10], (DEPTH, ATT_VD)),
        "dn_conv": nrm(ks[11], (DEPTH, DN_CONV, 3 * DN_W), DN_CONV ** -0.5),
        "dn_a_log": jnp.log(jax.random.uniform(ks[12], (DEPTH, DN_HEADS), jnp.float32, 1.0, 16.0)),
        "dn_dt_bias": dt_init + jnp.log(-jnp.expm1(-dt_init)),
        "dn_norm": gain(ks[14], (DEPTH, DN_HD)),
        "gla_w2": nrm(ks[15], (DEPTH, GLA_RANK, GLA_KW), GLA_RANK ** -0.5),
        "gla_b": nrm(ks[16], (DEPTH, GLA_KW), 0.01),
        "gla_norm": gain(ks[17], (DEPTH, GLA_VD)),
        "ple_proj": nrm(ks[18], (DEPTH, D_PLE, D_MODEL), D_PLE ** -0.5),
        "ple_gate": nrm(ks[19], (DEPTH, D_MODEL, D_MODEL), D_MODEL ** -0.5),
        "ple_norm": gain(ks[20], (DEPTH, D_MODEL)),
    }


def reference(x, p, w_in, w_out, pre_gain, post_gain, att_lq1, att_lk1, att_lq2, att_lk2,
              att_subln, dn_conv, dn_a_log, dn_dt_bias, dn_norm, gla_w2, gla_b, gla_norm,
              ple_proj, ple_gate, ple_norm):
    for i in range(DEPTH):
        x = hybrid_layer(x, p[i], w_in[i], w_out[i], pre_gain[i], post_gain[i],
                         att_lq1[i], att_lk1[i], att_lq2[i], att_lk2[i], att_subln[i],
                         dn_conv[i], dn_a_log[i], dn_dt_bias[i], dn_norm[i],
                         gla_w2[i], gla_b[i], gla_norm[i],
                         ple_proj[i], ple_gate[i], ple_norm[i], i)
    return x
```

```cpp
#include <hip/hip_runtime.h>
#include <cstdio>
#include <cstdint>
#include <cmath>
namespace pg8 {
#define PG8_LAS __attribute__((address_space(3)))
typedef unsigned short bf16_t;
typedef short bf16x8 __attribute__((ext_vector_type(8)));
typedef float f32x4 __attribute__((ext_vector_type(4)));
typedef unsigned u32x4 __attribute__((ext_vector_type(4)));
constexpr int BM = 256, BK = 64, HALF = 128, HTB = HALF * BK * 2  , STAGE_BYTES = 8 * HTB, NXCD = 8, WGM = 8;

__host__ __device__ __forceinline__ int lds_byte(int r, int c) { const int st = (r >> 4) * 2 + (c >> 5), rr = r & 15, cc = c & 31, ob = rr * 64 + cc * 2; return st * 1024 + (ob ^ (((ob >> 9) & 1) << 5)); }
__host__ __device__ __forceinline__ void stage_rc(int b, int& R, int& C) { const int st = b / 1024, sb = b % 1024, swz = sb ^ (((sb >> 9) & 1) << 5); R = (st >> 1) * 16 + swz / 64; C = (st & 1) * 32 + (swz % 64) / 2; }
__host__ __device__ __forceinline__ int perm32(int rho) { const int n = rho >> 4, i = rho & 15; return 8 * (i >> 2) + 4 * n + (i & 3); }

struct Unit { int pm, pn; };
struct Gemm { const bf16_t* A; const bf16_t* Bt; int M, N, K; };

struct StaticOrder {
    int nM, nN, nwg, G, c;
    __host__ __device__ void init(int M, int N, int G_, int c_) { nM = M / BM; nN = N / BM; nwg = nM * nN; G = G_; c = c_; }
    __host__ __device__ bool next(int i, Unit& u) const {
        const long L = (long)i * G + c; if (L >= nwg) return false;
        int wgid = (int)L; { const int q = nwg / NXCD, r = nwg % NXCD, xcd = wgid % NXCD, off = wgid / NXCD; wgid = (xcd < r ? xcd * (q + 1) : r * (q + 1) + (xcd - r) * q) + off; }
        const int nig = WGM * nN, gid = wgid / nig, fm = gid * WGM, gsz = (nM - fm) < WGM ? (nM - fm) : WGM;
        u.pm = fm + ((wgid % nig) % gsz); u.pn = (wgid % nig) / gsz; return true;
    }
    __device__ __forceinline__ void a_ready(const Unit&) const {}
    __device__ __forceinline__ void done(const Unit&) const {}
};

__device__ __forceinline__ unsigned cvt_pk_bf16(float lo, float hi) { unsigned r; asm volatile("v_cvt_pk_bf16_f32 %0, %1, %2" : "=v"(r) : "v"(lo), "v"(hi)); return r; }
typedef float f32x2 __attribute__((ext_vector_type(2)));
__device__ __forceinline__ float bf_lo(unsigned w) { return __builtin_bit_cast(float, w << 16); }
__device__ __forceinline__ float bf_hi(unsigned w) { return __builtin_bit_cast(float, w & 0xffff0000u); }
#define EPI_IDS() int t_ = threadIdx.x; asm volatile("" : "+v"(t_)); const int wid_ = t_ >> 6, wr = wid_ >> 2, wc = wid_ & 3, fr = t_ & 15, fq = (t_ & 63) >> 4
struct EpiProj {
    static constexpr bool PERM = true, AFTER_DRAIN = false;
    bf16_t* QKV;
    bf16_t* ZY;
    bf16_t* DNQ;
    bf16_t* GLQ;
    float* SM;
    float qscale;
    __device__ __forceinline__ void operator()(const f32x4 (&acc)[2][2][4][2], const Unit& u, int, int, int, int) const {
        EPI_IDS();
        const int pn = u.pn;
        const int row0 = u.pm * BM + wr * 64 + fr;
        if (pn == 30) {
            if (wc == 0) {
#pragma unroll
                for (int ai = 0; ai < 2; ++ai)
#pragma unroll
                    for (int m = 0; m < 4; ++m) { float* d = SM + (size_t)(row0 + ai * HALF + m * 16) * 32 + 8 * fq; *(f32x4*)d = acc[ai][0][m][0]; *(f32x4*)(d + 4) = acc[ai][0][m][1]; }
            }
            return;
        }
        bf16_t* base; int ldc, colt; float sc = 1.f;
        if (pn < 12) { base = QKV; ldc = 3072; colt = pn * 256; if (pn < 4) sc = qscale; }
        else if (pn < 16) { base = ZY; ldc = 2048; colt = (pn - 12) * 256; }
        else if (pn < 22) { base = DNQ; ldc = 1536; colt = (pn - 16) * 256; }
        else if (pn < 24) { base = ZY; ldc = 2048; colt = 1024 + (pn - 22) * 256; }
        else if (pn < 28) { base = GLQ; ldc = 1024; colt = (pn - 24) * 256; }
        else { base = ZY; ldc = 2048; colt = 1536 + (pn - 28) * 256; }
        const int col0 = colt + wc * 32 + 8 * fq;
#pragma unroll
        for (int ai = 0; ai < 2; ++ai)
#pragma unroll
            for (int m = 0; m < 4; ++m) { bf16_t* rowp = base + (size_t)(row0 + ai * HALF + m * 16) * ldc + col0;
#pragma unroll
                for (int bj = 0; bj < 2; ++bj) { const f32x4 v0 = acc[ai][bj][m][0] * sc, v1 = acc[ai][bj][m][1] * sc;
                    u32x4 w; w.x = cvt_pk_bf16(v0[0], v0[1]); w.y = cvt_pk_bf16(v0[2], v0[3]); w.z = cvt_pk_bf16(v1[0], v1[1]); w.w = cvt_pk_bf16(v1[2], v1[3]);
                    *(u32x4*)(rowp + bj * HALF) = w; } }
    }
};
struct EpiBf {
    static constexpr bool PERM = true, AFTER_DRAIN = false;
    bf16_t* O; int ldc;
    __device__ __forceinline__ void operator()(const f32x4 (&acc)[2][2][4][2], const Unit& u, int, int, int, int) const {
        EPI_IDS();
        const int row0 = u.pm * BM + wr * 64 + fr, col0 = u.pn * BM + wc * 32 + 8 * fq;
#pragma unroll
        for (int ai = 0; ai < 2; ++ai)
#pragma unroll
            for (int m = 0; m < 4; ++m) { bf16_t* rowp = O + (size_t)(row0 + ai * HALF + m * 16) * ldc + col0;
#pragma unroll
                for (int bj = 0; bj < 2; ++bj) { const f32x4 v0 = acc[ai][bj][m][0], v1 = acc[ai][bj][m][1];
                    u32x4 w; w.x = cvt_pk_bf16(v0[0], v0[1]); w.y = cvt_pk_bf16(v0[2], v0[3]); w.z = cvt_pk_bf16(v1[0], v1[1]); w.w = cvt_pk_bf16(v1[2], v1[3]);
                    *(u32x4*)(rowp + bj * HALF) = w; } }
    }
};
struct EpiF32 {
    static constexpr bool PERM = true, AFTER_DRAIN = false;
    float* O; int ldc;
    __device__ __forceinline__ void operator()(const f32x4 (&acc)[2][2][4][2], const Unit& u, int, int, int, int) const {
        EPI_IDS();
        const int row0 = u.pm * BM + wr * 64 + fr, col0 = u.pn * BM + wc * 32 + 8 * fq;
#pragma unroll
        for (int ai = 0; ai < 2; ++ai)
#pragma unroll
            for (int m = 0; m < 4; ++m) { float* rowp = O + (size_t)(row0 + ai * HALF + m * 16) * ldc + col0;
#pragma unroll
                for (int bj = 0; bj < 2; ++bj) { *(f32x4*)(rowp + bj * HALF) = acc[ai][bj][m][0]; *(f32x4*)(rowp + bj * HALF + 4) = acc[ai][bj][m][1]; } }
    }
};
struct EpiGate {
    static constexpr bool PERM = true, AFTER_DRAIN = false;
    const bf16_t* PP; float* O; int ldc;
    __device__ __forceinline__ void operator()(const f32x4 (&acc)[2][2][4][2], const Unit& u, int, int, int, int) const {
        EPI_IDS();
        const int row0 = u.pm * BM + wr * 64 + fr, col0 = u.pn * BM + wc * 32 + 8 * fq;
#pragma unroll
        for (int ai = 0; ai < 2; ++ai)
#pragma unroll
            for (int m = 0; m < 4; ++m) { const size_t off = (size_t)(row0 + ai * HALF + m * 16) * ldc + col0;
#pragma unroll
                for (int bj = 0; bj < 2; ++bj) { const u32x4 pw = *(const u32x4*)(PP + off + bj * HALF);
                    const f32x4 a0 = acc[ai][bj][m][0], a1 = acc[ai][bj][m][1];
                    f32x4 o0, o1;
                    o0[0] = bf_lo(pw.x) / (1.f + __expf(-a0[0])); o0[1] = bf_hi(pw.x) / (1.f + __expf(-a0[1]));
                    o0[2] = bf_lo(pw.y) / (1.f + __expf(-a0[2])); o0[3] = bf_hi(pw.y) / (1.f + __expf(-a0[3]));
                    o1[0] = bf_lo(pw.z) / (1.f + __expf(-a1[0])); o1[1] = bf_hi(pw.z) / (1.f + __expf(-a1[1]));
                    o1[2] = bf_lo(pw.w) / (1.f + __expf(-a1[2])); o1[3] = bf_hi(pw.w) / (1.f + __expf(-a1[3]));
                    *(f32x4*)(O + off + bj * HALF) = o0; *(f32x4*)(O + off + bj * HALF + 4) = o1; } }
    }
};
template <class Epi, class Sched, bool ALIGN_EPI = false, bool SP2 = false>
__device__ __forceinline__ void gemm_phase(PG8_LAS unsigned char* lds, const Gemm g, const Sched& S, const Epi& E) {
    int tid_ = threadIdx.x; asm volatile("" : "+v"(tid_));
    const int tid = tid_, wid = __builtin_amdgcn_readfirstlane(tid >> 6), lane = tid & 63, wr = wid >> 2, wc = wid & 3, fr = lane & 15, fq = lane >> 4;
    const int K = g.K, nt = K / BK;
    unsigned voffA[2], voffB[2];
#pragma unroll
    for (int i = 0; i < 2; ++i) { int R, C; stage_rc(tid * 16 + i * 8192, R, C); const int Rb = Epi::PERM ? ((R & ~31) + perm32(R & 31)) : R;
        voffA[i] = (unsigned)(R * K + C) * 2u; voffB[i] = (unsigned)(Rb * K + C) * 2u; }
    const size_t kstep = (size_t)(BK * 2);
    const size_t hstep = (size_t)HALF * K * 2;
    const size_t tstep = 2 * hstep;
    const unsigned ldsw = (unsigned)wid * 1024u;
    const int aoff = lds_byte(wr * 64 + fr, fq * 8), boff = lds_byte(wc * 32 + fr, fq * 8);
#define PG8_SA(b, h) (((b) * 2 + (h)) * HTB)
#define PG8_SB(b, h) ((4 + (b) * 2 + (h)) * HTB)
#define PG8_STAGE(bufoff, gbase, voff) do { _Pragma("unroll") for (int _i = 0; _i < 2; ++_i) \
        __builtin_amdgcn_global_load_lds((const unsigned*)((const char*)(gbase) + (voff)[_i]), (PG8_LAS unsigned*)(lds + (bufoff) + ldsw + _i * 8192), 16, 0, 0); } while (0)
#define PG8_LDA(dst, b, h) do { _Pragma("unroll") for (int m = 0; m < 4; ++m) _Pragma("unroll") for (int k = 0; k < 2; ++k) dst[m][k] = *(const PG8_LAS bf16x8*)(lds + PG8_SA(b, h) + aoff + m * 2048 + k * 1024); } while (0)
#define PG8_LDB(dst, b, h) do { _Pragma("unroll") for (int n = 0; n < 2; ++n) _Pragma("unroll") for (int k = 0; k < 2; ++k) dst[n][k] = *(const PG8_LAS bf16x8*)(lds + PG8_SB(b, h) + boff + n * 2048 + k * 1024); } while (0)
#define PG8_MMA(ai, bj, At, Bt) do { __builtin_amdgcn_s_setprio(1); _Pragma("unroll") for (int m = 0; m < 4; ++m) _Pragma("unroll") for (int n = 0; n < 2; ++n) _Pragma("unroll") for (int k = 0; k < 2; ++k) \
        acc[ai][bj][m][n] = __builtin_amdgcn_mfma_f32_16x16x32_bf16(Bt[n][k], At[m][k], acc[ai][bj][m][n], 0, 0, 0); __builtin_amdgcn_s_setprio(0); } while (0)
#define PG8_WAIT_V(n) asm volatile("s_waitcnt vmcnt(" #n ")" ::: "memory")
#define PG8_WAIT_L(n) asm volatile("s_waitcnt lgkmcnt(" #n ")" ::: "memory")
#define PG8_BAR __builtin_amdgcn_s_barrier()
#define PG8_SCHED __builtin_amdgcn_sched_barrier(0)
    Unit cur, nxt; int ui = 0;
    if (!S.next(0, cur)) return;
    f32x4 acc[2][2][4][2];
#pragma unroll
    for (int a = 0; a < 2; ++a)
#pragma unroll
        for (int b = 0; b < 2; ++b)
#pragma unroll
            for (int m = 0; m < 4; ++m)
#pragma unroll
                for (int n = 0; n < 2; ++n) acc[a][b][m][n] = (f32x4){0.f, 0.f, 0.f, 0.f};
    bf16x8 At[4][2], B0[2][2], B1[2][2];
    const char* cA = (const char*)g.A + (size_t)cur.pm * tstep; const char* cB = (const char*)g.Bt + (size_t)cur.pn * tstep;
    S.a_ready(cur);
    if constexpr (SP2) {
        PG8_STAGE(PG8_SB(0, 0), cB, voffB); PG8_STAGE(PG8_SB(0, 1), cB + hstep, voffB); PG8_STAGE(PG8_SA(0, 0), cA, voffA); PG8_STAGE(PG8_SA(0, 1), cA + hstep, voffA);
        if (wr == 1) PG8_BAR;
        PG8_WAIT_V(2); PG8_BAR;
        PG8_STAGE(PG8_SB(1, 0), cB + kstep, voffB); PG8_STAGE(PG8_SA(1, 0), cA + kstep, voffA); PG8_STAGE(PG8_SB(1, 1), cB + hstep + kstep, voffB);
        PG8_WAIT_V(6); PG8_BAR;
    } else {
        PG8_STAGE(PG8_SB(0, 0), cB, voffB); PG8_STAGE(PG8_SA(0, 0), cA, voffA); PG8_STAGE(PG8_SB(0, 1), cB + hstep, voffB); PG8_STAGE(PG8_SA(0, 1), cA + hstep, voffA);
        if (wr == 1) PG8_BAR;
        PG8_WAIT_V(4); PG8_BAR;
        PG8_STAGE(PG8_SB(1, 0), cB + kstep, voffB); PG8_STAGE(PG8_SA(1, 0), cA + kstep, voffA); PG8_STAGE(PG8_SB(1, 1), cB + hstep + kstep, voffB);
        PG8_WAIT_V(6); PG8_BAR;
    }
    for (;;) {
        const bool has_next = S.next(ui + 1, nxt);
        const char* nA = has_next ? (const char*)g.A + (size_t)nxt.pm * tstep : cA; const char* nB = has_next ? (const char*)g.Bt + (size_t)nxt.pn * tstep : cB;
        for (int t = 0; t < nt; t += 2) {
            const bool last = (t == nt - 2);
            const char* a1 = cA + (size_t)(t + 1) * kstep;
            const char* a2 = last ? nA : cA + (size_t)(t + 2) * kstep; const char* b2 = last ? nB : cB + (size_t)(t + 2) * kstep;
            const char* a3 = a2 + kstep; const char* b3 = b2 + kstep;
            if (last && has_next) S.a_ready(nxt);
            if constexpr (SP2) {
            PG8_LDB(B0, 0, 0); PG8_LDB(B1, 0, 1); PG8_SCHED; PG8_LDA(At, 0, 0); PG8_STAGE(PG8_SA(1, 1), a1 + hstep, voffA);
            PG8_WAIT_V(8); PG8_WAIT_L(0); PG8_BAR; PG8_MMA(0, 0, At, B0); PG8_MMA(0, 1, At, B1); PG8_BAR; PG8_SCHED;
            PG8_LDA(At, 0, 1); PG8_STAGE(PG8_SB(0, 0), b2, voffB); PG8_STAGE(PG8_SB(0, 1), b2 + hstep, voffB); PG8_STAGE(PG8_SA(0, 0), a2, voffA);
            PG8_WAIT_V(8); PG8_WAIT_L(0); PG8_BAR; PG8_MMA(1, 0, At, B0); PG8_MMA(1, 1, At, B1); PG8_BAR; PG8_SCHED;
            PG8_LDB(B0, 1, 0); PG8_LDB(B1, 1, 1); PG8_SCHED; PG8_LDA(At, 1, 0); PG8_STAGE(PG8_SA(0, 1), a2 + hstep, voffA);
            PG8_WAIT_V(8); PG8_WAIT_L(0); PG8_BAR; PG8_MMA(0, 0, At, B0); PG8_MMA(0, 1, At, B1); PG8_BAR; PG8_SCHED;
            PG8_LDA(At, 1, 1); PG8_STAGE(PG8_SB(1, 0), b3, voffB); PG8_STAGE(PG8_SB(1, 1), b3 + hstep, voffB); PG8_STAGE(PG8_SA(1, 0), a3, voffA);
            PG8_WAIT_V(8); PG8_WAIT_L(0); PG8_BAR; PG8_MMA(1, 0, At, B0); PG8_MMA(1, 1, At, B1); PG8_BAR; PG8_SCHED;
            } else {
            PG8_LDB(B0, 0, 0); PG8_SCHED; PG8_LDA(At, 0, 0); PG8_STAGE(PG8_SA(1, 1), a1 + hstep, voffA);
            PG8_WAIT_L(8); PG8_BAR; PG8_WAIT_L(0); PG8_MMA(0, 0, At, B0); PG8_BAR; PG8_SCHED;
            PG8_LDB(B1, 0, 1); PG8_STAGE(PG8_SB(0, 0), b2, voffB);
            PG8_BAR; PG8_WAIT_L(0); PG8_MMA(0, 1, At, B1); PG8_BAR;
            PG8_LDA(At, 0, 1); PG8_STAGE(PG8_SA(0, 0), a2, voffA);
            PG8_BAR; PG8_WAIT_L(0); PG8_MMA(1, 0, At, B0); PG8_BAR; PG8_SCHED;
            PG8_STAGE(PG8_SB(0, 1), b2 + hstep, voffB);
            PG8_WAIT_V(6); PG8_BAR; PG8_MMA(1, 1, At, B1); PG8_BAR;
            PG8_LDB(B0, 1, 0); PG8_SCHED; PG8_LDA(At, 1, 0); PG8_STAGE(PG8_SA(0, 1), a2 + hstep, voffA);
            PG8_WAIT_L(8); PG8_BAR; PG8_WAIT_L(0); PG8_MMA(0, 0, At, B0); PG8_BAR; PG8_SCHED;
            PG8_LDB(B1, 1, 1); PG8_STAGE(PG8_SB(1, 0), b3, voffB);
            PG8_BAR; PG8_WAIT_L(0); PG8_MMA(0, 1, At, B1); PG8_BAR;
            PG8_LDA(At, 1, 1); PG8_STAGE(PG8_SA(1, 0), a3, voffA);
            PG8_BAR; PG8_WAIT_L(0); PG8_MMA(1, 0, At, B0); PG8_BAR; PG8_SCHED;
            PG8_STAGE(PG8_SB(1, 1), b3 + hstep, voffB);
            PG8_WAIT_V(6); PG8_BAR; PG8_MMA(1, 1, At, B1); PG8_BAR;
            }
        }
        if constexpr (ALIGN_EPI) { if (wr == 0) PG8_BAR; }
        if constexpr (!Epi::AFTER_DRAIN) { E(acc, cur, wr, wc, fr, fq); S.done(cur); }
        if (!has_next) break;
#pragma unroll
        for (int a = 0; a < 2; ++a)
#pragma unroll
            for (int b = 0; b < 2; ++b)
#pragma unroll
                for (int m = 0; m < 4; ++m)
#pragma unroll
                    for (int n = 0; n < 2; ++n) acc[a][b][m][n] = (f32x4){0.f, 0.f, 0.f, 0.f};
        cur = nxt; cA = nA; cB = nB; ++ui;
        if constexpr (ALIGN_EPI) { if (wr == 1) PG8_BAR; }
    }
    PG8_WAIT_V(0);
    if constexpr (!ALIGN_EPI) { if (wr == 0) PG8_BAR; }
    PG8_BAR;
    if constexpr (Epi::AFTER_DRAIN) { E.fused(acc, cur, wr, wc, fr, fq, lds, wid, lane); S.done(cur); }
#undef PG8_SA
#undef PG8_SB
#undef PG8_STAGE
#undef PG8_LDA
#undef PG8_LDB
#undef PG8_MMA
#undef PG8_WAIT_V
#undef PG8_WAIT_L
#undef PG8_BAR
#undef PG8_SCHED
}
}
#define GAS __attribute__((address_space(1)))
#define LAS __attribute__((address_space(3)))
typedef unsigned short bf16;
typedef unsigned v4u __attribute__((ext_vector_type(4)));
typedef float f32x4 __attribute__((ext_vector_type(4)));
typedef short bf16x8 __attribute__((ext_vector_type(8)));
typedef GAS unsigned gu32;
typedef GAS unsigned long long gu64;
#define RLX_AGENT __ATOMIC_RELAXED, __HIP_MEMORY_SCOPE_AGENT
#define LDS_WAIT() asm volatile("s_waitcnt lgkmcnt(0)" ::: "memory")
#define VM_WAIT() asm volatile("s_waitcnt vmcnt(0)" ::: "memory")
__device__ __forceinline__ unsigned long long rt() { return __builtin_amdgcn_s_memrealtime(); }
__device__ __forceinline__ unsigned f2bf(float f) { unsigned u = __builtin_bit_cast(unsigned, f); return (u + 0x7fffu + ((u >> 16) & 1u)) >> 16; }
__device__ __forceinline__ unsigned pk2(float lo, float hi) { return f2bf(lo) | (f2bf(hi) << 16); }

#define XB_TMO      128
#define XB_XCNT(j)  (256  + 64 * (j))
#define XB_XSUB(j)  (1280 + 64 * (j))
#define XB_XGEN(j)  (2304 + 64 * (j))
#define XB_TOP      3328
#define XB_TOPGEN   3392
#define XCD_BAR_WORDS 3456
#define XB_SPIN_CAP (1u << 18)

__device__ __forceinline__ unsigned xb_ld(unsigned* p)              { return __hip_atomic_load(p, __ATOMIC_RELAXED, __HIP_MEMORY_SCOPE_AGENT); }
__device__ __forceinline__ unsigned xb_add(unsigned* p, unsigned v) { return __hip_atomic_fetch_add(p, v, __ATOMIC_RELAXED, __HIP_MEMORY_SCOPE_AGENT); }
__device__ __forceinline__ unsigned xb_xcc_id() { return (unsigned)__builtin_amdgcn_s_getreg((3 << 11) | 20) & 0xFu; }
#define XB_SPIN(cond, bar) do { unsigned _sp = 0; while (cond) { __builtin_amdgcn_s_sleep(1); \
    if ((++_sp & 255u) == 0u) { if (xb_ld(&(bar)[XB_TMO])) break; if (_sp > XB_SPIN_CAP) { atomicAdd(&(bar)[XB_TMO], 1u); break; } } } } while (0)

struct XcdBarrier {
    unsigned* bar; unsigned x;
    volatile LAS unsigned* st;
};

__device__ __forceinline__ XcdBarrier xcd_barrier_post(unsigned* bar, volatile LAS unsigned* st) {
    XcdBarrier b; b.bar = bar; b.x = xb_xcc_id(); b.st = st;
    if (threadIdx.x == 0) (void)xb_add(&bar[XB_XCNT(b.x)], 1u);
    return b;
}
__device__ __forceinline__ void xcd_barrier_complete(unsigned* bar, unsigned x, unsigned& nloc, unsigned& nx) {
    const unsigned G = gridDim.x * gridDim.y * gridDim.z;
    unsigned sum, cnt, mine, sp = 0u;
    for (;;) {
        sum = 0u; cnt = 0u; mine = 0u;
#pragma unroll
        for (unsigned j = 0; j < 16; ++j) { const unsigned c = xb_ld(&bar[XB_XCNT(j)]); sum += c; cnt += (c > 0u) ? 1u : 0u; mine = (j == x) ? c : mine; }
        if (sum == G) break;
        __builtin_amdgcn_s_sleep(1);
        if ((++sp & 255u) == 0u) { if (xb_ld(&bar[XB_TMO])) break; if (sp > XB_SPIN_CAP) { atomicAdd(&bar[XB_TMO], 1u); break; } }
    }
    nloc = mine > 0u ? mine : 1u; nx = cnt > 0u ? cnt : 1u;
}

__device__ __forceinline__ void xcd_barrier(const XcdBarrier& b) {
    asm volatile("s_waitcnt vmcnt(0)" ::: "memory");
    __syncthreads();
    if (threadIdx.x == 0) {
        unsigned* bar = b.bar;
        __builtin_amdgcn_s_waitcnt(0);
        unsigned nloc = b.st[0], nx = b.st[1];
        if (nloc == 0u) { xcd_barrier_complete(bar, b.x, nloc, nx); b.st[0] = nloc; b.st[1] = nx; }
        const unsigned old = xb_add(&bar[XB_XSUB(b.x)], 1u);
        const unsigned gen = old / nloc;
        if (old + 1u == (gen + 1u) * nloc) {
            __builtin_amdgcn_fence(__ATOMIC_RELEASE, "agent");
            asm volatile("s_waitcnt vmcnt(0)" ::: "memory");
            const unsigned og = xb_add(&bar[XB_TOP], 1u);
            const unsigned tg = og / nx;
            if (og + 1u == (tg + 1u) * nx) xb_add(&bar[XB_TOPGEN], 1u);
            else XB_SPIN(xb_ld(&bar[XB_TOPGEN]) == tg, bar);
            __builtin_amdgcn_fence(__ATOMIC_ACQUIRE, "agent");
            xb_add(&bar[XB_XGEN(b.x)], 1u);
            asm volatile("s_waitcnt vmcnt(0)" ::: "memory");
        } else {
            XB_SPIN(xb_ld(&bar[XB_XGEN(b.x)]) == gen, bar);
            __builtin_amdgcn_fence(__ATOMIC_ACQUIRE, "agent");
            asm volatile("s_waitcnt vmcnt(0)" ::: "memory");
        }
    }
    __syncthreads();
}

constexpr int NWAVES = 8, NTHR = 512;
constexpr int SEQ = 2048, DM = 1024, NTOK = 16384, HBROWS = 8192;
constexpr int D_IN = 7704, NPROJ = 7936;
constexpr float EPS = 1e-6f;
constexpr float LOG2E = 1.4426950408889634f;
constexpr int C_DB = 6144, C_GQ = 6152, C_GR = 7688;
constexpr size_t MiB = 1u << 20;
constexpr size_t WS_CTL = 0, CTL_ZERO_BYTES = 65536;
constexpr size_t WS_WIN = 1 * MiB, WS_WOUT = 17 * MiB, WS_WG = 21 * MiB, WS_WP = 23 * MiB;
constexpr size_t WS_H = 24 * MiB, WS_ZY = 56 * MiB;
constexpr size_t WS_QKV = 120 * MiB, WS_DNQ = 168 * MiB, WS_GLQ = 192 * MiB, WS_SM = 208 * MiB, WS_DNC = 209 * MiB, WS_GK = 233 * MiB;
constexpr size_t WS_T1 = 120 * MiB, WS_PP = 184 * MiB, WS_XB = 216 * MiB, WS_PBF = 248 * MiB, WS_END = 256 * MiB;
constexpr int CW_BAR = 1024;
static_assert((CW_BAR + XCD_BAR_WORDS) * 4 <= (int)CTL_ZERO_BYTES, "ctl");
constexpr int RING_BYTES = 131072, LDSCTL_OFF = RING_BYTES, MISC_OFF = LDSCTL_OFF + 320, LDS_BYTES = 147456;

__device__ __forceinline__ float wave_sum(float v) {
#pragma unroll
    for (int o = 1; o < 64; o <<= 1) v += __shfl_xor(v, o);
    return v;
}
__device__ __forceinline__ float wave_max(float v) {
#pragma unroll
    for (int o = 1; o < 64; o <<= 1) v = fmaxf(v, __shfl_xor(v, o));
    return v;
}
__device__ __forceinline__ float silu_f(float x) { return x / (1.f + __expf(-x)); }
__device__ __forceinline__ float sigmoid_f(float x) { return 1.f / (1.f + __expf(-x)); }
__device__ __forceinline__ float softplus_f(float x) { return fmaxf(x, 0.f) + log1pf(__expf(-fabsf(x))); }
__device__ __forceinline__ float bflo(unsigned w) { return __builtin_bit_cast(float, w << 16); }
__device__ __forceinline__ float bfhi(unsigned w) { return __builtin_bit_cast(float, w & 0xffff0000u); }
__device__ __forceinline__ float bf2f(bf16 h) { return __builtin_bit_cast(float, (unsigned)h << 16); }

struct Frame {
    LAS unsigned char* lds;
    int tid, lane, wave, vcu, G, gw, NGW, bx;
};
#define CAS __attribute__((address_space(4)))
#define PHASE_BEGIN() do { int t_ = threadIdx.x; asm volatile("" : "+v"(t_)); F.tid = t_; F.lane = t_ & 63; F.wave = __builtin_amdgcn_readfirstlane(t_ >> 6); \
    { int bx_ = blockIdx.x; asm volatile("" : "+s"(bx_)); F.vcu = (bx_ % 8) * (F.G / 8) + bx_ / 8; F.bx = bx_; } F.gw = F.vcu * NWAVES + F.wave; kp = (const CAS unsigned char*)__builtin_amdgcn_kernarg_segment_ptr(); asm volatile("" : "+s"(kp)); } while (0)
#define INP(k) (((const float* const CAS*)kp)[k])
#define OUTP   (((float* const CAS*)kp)[21])
#define WSP    (((unsigned char* const CAS*)kp)[22])
enum { IN_X = 0, IN_P, IN_WIN, IN_WOUT, IN_PREG, IN_POSTG, IN_LQ1, IN_LK1, IN_LQ2, IN_LK2, IN_SUBLN, IN_DNCONV, IN_ALOG, IN_DTB, IN_DNNORM, IN_GW2, IN_GB, IN_GNORM, IN_PPROJ, IN_PGATE, IN_PNORM };

__device__ __forceinline__ void transpose_item(const float* W, int ldw, int src0, bf16* WT, int K, int dst0, int nblk, LAS float* scr, int item, int lane) {
    const int kb = item / nblk, nb = item % nblk, k0 = 64 * kb, n0 = 32 * nb;
#pragma unroll 8
    for (int i = 0; i < 32; ++i) { const int kk = 2 * i + (lane >> 5); scr[kk * 33 + (lane & 31)] = W[(size_t)(k0 + kk) * ldw + src0 + n0 + (lane & 31)]; }
    LDS_WAIT(); asm volatile("" ::: "memory");
    const int c = lane & 7;
#pragma unroll
    for (int j = 0; j < 4; ++j) { const int n = (lane >> 3) + 8 * j; const LAS float* s = scr + (8 * c) * 33 + n;
        v4u o; o.x = pk2(s[0 * 33], s[1 * 33]); o.y = pk2(s[2 * 33], s[3 * 33]); o.z = pk2(s[4 * 33], s[5 * 33]); o.w = pk2(s[6 * 33], s[7 * 33]);
        *(GAS v4u*)(WT + (size_t)(dst0 + n0 + n) * K + k0 + 8 * c) = o; }
    LDS_WAIT(); asm volatile("" ::: "memory");
}
__device__ __forceinline__ void convert_weights(const Frame& F, const float* w_in0, const float* w_out0, const float* wg0, const float* wp0, unsigned char* ws, int l) {
    LAS float* scr = (LAS float*)(F.lds + F.wave * 16384);
    const float* w_in = w_in0 + (size_t)l * 1024 * D_IN; const float* w_out = w_out0 + (size_t)l * 2048 * 1024;
    const float* wg = wg0 + (size_t)l * 1024 * 1024; const float* wp = wp0 + (size_t)l * 256 * 1024;
    bf16* WIN = (bf16*)(ws + WS_WIN); bf16* WOUT = (bf16*)(ws + WS_WOUT); bf16* WG = (bf16*)(ws + WS_WG); bf16* WP = (bf16*)(ws + WS_WP);
    constexpr int I_A = 16 * 192, I_B = 16 * 48, I_O = 32 * 32, I_G = 16 * 32, I_P = 4 * 32, I_S = 256;
    constexpr int NIT = I_A + I_B + I_O + I_G + I_P + I_S;
    for (int it = F.gw; it < NIT; it += F.NGW) {
        int r = it;
        if (r < I_A) { transpose_item(w_in, D_IN, 0, WIN, 1024, 0, 192, scr, r, F.lane); continue; } r -= I_A;
        if (r < I_B) { transpose_item(w_in, D_IN, C_GQ, WIN, 1024, 6144, 48, scr, r, F.lane); continue; } r -= I_B;
        if (r < I_O) { transpose_item(w_out, 1024, 0, WOUT, 2048, 0, 32, scr, r, F.lane); continue; } r -= I_O;
        if (r < I_G) { transpose_item(wg, 1024, 0, WG, 1024, 0, 32, scr, r, F.lane); continue; } r -= I_G;
        if (r < I_P) { transpose_item(wp, 1024, 0, WP, 256, 0, 32, scr, r, F.lane); continue; } r -= I_P;
        const int src = r < 8 ? C_DB + r : (r < 24 ? C_GR + (r - 8) : -1);
#pragma unroll 4
        for (int j = 0; j < 16; ++j) { const int k = F.lane + 64 * j; const float v = src >= 0 ? w_in[(size_t)k * D_IN + src] : 0.f; WIN[(size_t)(7680 + r) * 1024 + k] = (bf16)f2bf(v); }
    }
}
__device__ __forceinline__ void rms_row_to_bf16(const float* xrow, const float* g, bf16* orow, int lane) {
    const GAS f32x4* xr = (const GAS f32x4*)xrow + lane; const GAS f32x4* gr = (const GAS f32x4*)g + lane;
    f32x4 v[4]; float s = 0.f;
#pragma unroll
    for (int j = 0; j < 4; ++j) { v[j] = xr[64 * j]; s += (v[j].x * v[j].x + v[j].y * v[j].y) + (v[j].z * v[j].z + v[j].w * v[j].w); }
    const float rs = rsqrtf(wave_sum(s) * (1.f / 1024.f) + EPS);
    GAS unsigned long long* o8 = (GAS unsigned long long*)orow + lane;
#pragma unroll
    for (int j = 0; j < 4; ++j) { const f32x4 gg = gr[64 * j]; o8[64 * j] = (unsigned long long)pk2(v[j].x * rs * gg.x, v[j].y * rs * gg.y) | ((unsigned long long)pk2(v[j].z * rs * gg.z, v[j].w * rs * gg.w) << 32); }
}
__device__ __forceinline__ void norm_res_row(const float* xi, const float* t, const float* g, float* xo, bf16* xb, const float* g2, bf16* hn, int lane) {
    const GAS f32x4* tr = (const GAS f32x4*)t + lane; const GAS f32x4* gr = (const GAS f32x4*)g + lane; const GAS f32x4* xr = (const GAS f32x4*)xi + lane;
    f32x4 v[4]; float s = 0.f;
#pragma unroll
    for (int j = 0; j < 4; ++j) { v[j] = tr[64 * j]; s += (v[j].x * v[j].x + v[j].y * v[j].y) + (v[j].z * v[j].z + v[j].w * v[j].w); }
    const float rs = rsqrtf(wave_sum(s) * (1.f / 1024.f) + EPS);
    float s2 = 0.f;
#pragma unroll
    for (int j = 0; j < 4; ++j) { const f32x4 gg = gr[64 * j]; const f32x4 xx = xr[64 * j]; v[j] = xx + v[j] * rs * gg; s2 += (v[j].x * v[j].x + v[j].y * v[j].y) + (v[j].z * v[j].z + v[j].w * v[j].w);
        ((GAS f32x4*)xo + lane)[64 * j] = v[j]; }
    if (xb) { GAS unsigned long long* o8 = (GAS unsigned long long*)xb + lane;
#pragma unroll
        for (int j = 0; j < 4; ++j) o8[64 * j] = (unsigned long long)pk2(v[j].x, v[j].y) | ((unsigned long long)pk2(v[j].z, v[j].w) << 32); }
    if (hn) { const float rs2 = rsqrtf(wave_sum(s2) * (1.f / 1024.f) + EPS); const GAS f32x4* g2r = (const GAS f32x4*)g2 + lane; GAS unsigned long long* o8 = (GAS unsigned long long*)hn + lane;
#pragma unroll
        for (int j = 0; j < 4; ++j) { const f32x4 gg = g2r[64 * j]; o8[64 * j] = (unsigned long long)pk2(v[j].x * rs2 * gg.x, v[j].y * rs2 * gg.y) | ((unsigned long long)pk2(v[j].z * rs2 * gg.z, v[j].w * rs2 * gg.w) << 32); } }
}

__device__ __forceinline__ void dn_conv_item(const bf16* DNQ, const float* convw, bf16* DNC, int item, int lane) {
    const int g = item % 12, row = item / 12, t = row & (SEQ - 1);
    const int c = g * 128 + 2 * lane;
    float a0 = 0.f, a1 = 0.f;
#pragma unroll
    for (int j = 0; j < 4; ++j) { const int tt = t - 3 + j; if (tt >= 0) { const unsigned w = *(const unsigned*)(DNQ + (size_t)(row - 3 + j) * 1536 + c); a0 += convw[j * 1536 + c] * bflo(w); a1 += convw[j * 1536 + c + 1] * bfhi(w); } }
    float y0 = silu_f(a0), y1 = silu_f(a1);
    if (g < 8) { float rs = rsqrtf(wave_sum(y0 * y0 + y1 * y1) + EPS); if (g < 4) rs *= 0.08838834764831845f; y0 *= rs; y1 *= rs; }
    *(unsigned*)(DNC + (size_t)row * 1536 + c) = pk2(y0, y1);
}
__device__ __forceinline__ void gla_gk_item(const float* SM, const float* w2, const float* bias, float* GK, int item, int lane) {
    const int row = item >> 2, c = (item & 3) * 64 + lane;
    float a = bias[c];
#pragma unroll
    for (int r = 0; r < 16; ++r) a += SM[(size_t)row * 32 + 8 + r] * w2[r * 256 + c];
    const float ls = fminf(a, 0.f) - log1pf(__expf(-fabsf(a)));
    GK[(size_t)row * 256 + c] = ls * (1.f / 16.f);
}
__device__ __forceinline__ void dn_scan_naive(const Frame& F, const bf16* DNC, const float* SM, const float* a_log, const float* dt_bias, const float* gain, bf16* ZYh, int unit) {
    LAS float* kq = (LAS float*)(F.lds);
    LAS float* part = (LAS float*)(F.lds + 4096);
    LAS float* ssp = (LAS float*)(F.lds + 8192);
    const int sub = F.tid >> 8, tl = F.tid & 255, e = tl & 127, half = tl >> 7;
    const int u = unit + sub, bl = u >> 2, h = u & 3;
    float S[64];
#pragma unroll
    for (int d = 0; d < 64; ++d) S[d] = 0.f;
    const float A = -__expf(a_log[h]); const float dtb = dt_bias[h];
    for (int t = 0; t < SEQ; ++t) {
        const int row = bl * SEQ + t, bf = t & 1;
        const bf16* dr = DNC + (size_t)row * 1536;
        kq[(sub * 2 + bf) * 256 + tl] = (tl < 128) ? bf2f(dr[512 + h * 128 + tl]) : bf2f(dr[h * 128 + (tl - 128)]);
        const float v = bf2f(dr[1024 + h * 128 + e]);
        const float beta = sigmoid_f(SM[(size_t)row * 32 + h]);
        const float a = __expf(A * softplus_f(SM[(size_t)row * 32 + 4 + h] + dtb));
        __syncthreads();
        const LAS float* kk = kq + (sub * 2 + bf) * 256 + half * 64; const LAS float* qq = kk + 128;
        float r = 0.f;
#pragma unroll
        for (int d = 0; d < 64; ++d) r += S[d] * kk[d];
        part[((sub * 2 + bf) * 2 + half) * 128 + e] = r;
        __syncthreads();
        const float rr = part[((sub * 2 + bf) * 2 + 0) * 128 + e] + part[((sub * 2 + bf) * 2 + 1) * 128 + e];
        const float vnew = beta * (v - a * rr);
        float o = 0.f;
#pragma unroll
        for (int d = 0; d < 64; ++d) { S[d] = a * S[d] + kk[d] * vnew; o += S[d] * qq[d]; }
        __syncthreads();
        part[((sub * 2 + bf) * 2 + half) * 128 + e] = o;
        __syncthreads();
        float ot = 0.f;
        if (half == 0) { ot = part[((sub * 2 + bf) * 2 + 0) * 128 + e] + part[((sub * 2 + bf) * 2 + 1) * 128 + e]; const float ss = wave_sum(ot * ot); if ((tl & 63) == 0) ssp[(sub * 2 + bf) * 2 + (tl >> 6)] = ss; }
        __syncthreads();
        if (half == 0) { const float rs = rsqrtf((ssp[(sub * 2 + bf) * 2] + ssp[(sub * 2 + bf) * 2 + 1]) * (1.f / 128.f) + EPS);
            bf16* zp = ZYh + (size_t)row * 2048 + 1024 + h * 128 + e; const float z = bf2f(*zp); *zp = (bf16)f2bf(ot * rs * gain[e] * silu_f(z)); }
    }
}
__device__ __forceinline__ void gla_scan_naive(const Frame& F, const bf16* GLQ, const float* GK, const float* gain, bf16* ZYh, int unit) {
    LAS float* qa = (LAS float*)(F.lds);
    LAS float* part = (LAS float*)(F.lds + 4096);
    LAS float* ssp = (LAS float*)(F.lds + 8192);
    const int sub = F.tid >> 8, tl = F.tid & 255, e = tl & 127, half = tl >> 7;
    const int u = unit + sub, bl = u >> 2, h = u & 3;
    float S[32];
#pragma unroll
    for (int d = 0; d < 32; ++d) S[d] = 0.f;
    for (int t = 0; t < SEQ; ++t) {
        const int row = bl * SEQ + t, bf = t & 1;
        const bf16* gr = GLQ + (size_t)row * 1024;
        LAS float* q3 = qa + (sub * 2 + bf) * 192;
        if (tl < 64) q3[tl] = __expf(GK[(size_t)row * 256 + h * 64 + tl]);
        else if (tl < 128) q3[tl] = bf2f(gr[256 + h * 64 + tl - 64]);
        else if (tl < 192) q3[tl] = bf2f(gr[h * 64 + tl - 128]) * 0.125f;
        const float v = bf2f(gr[512 + h * 128 + e]);
        __syncthreads();
        float o = 0.f;
#pragma unroll
        for (int d = 0; d < 32; ++d) { const int dd = half * 32 + d; S[d] = q3[dd] * S[d] + q3[64 + dd] * v; o += q3[128 + dd] * S[d]; }
        part[((sub * 2 + bf) * 2 + half) * 128 + e] = o;
        __syncthreads();
        float ot = 0.f;
        if (half == 0) { ot = part[((sub * 2 + bf) * 2 + 0) * 128 + e] + part[((sub * 2 + bf) * 2 + 1) * 128 + e]; const float ss = wave_sum(ot * ot); if ((tl & 63) == 0) ssp[(sub * 2 + bf) * 2 + (tl >> 6)] = ss; }
        __syncthreads();
        if (half == 0) { const float rs = rsqrtf((ssp[(sub * 2 + bf) * 2] + ssp[(sub * 2 + bf) * 2 + 1]) * (1.f / 128.f) + EPS);
            bf16* zp = ZYh + (size_t)row * 2048 + 1536 + h * 128 + e; const float z = bf2f(*zp); *zp = (bf16)f2bf(ot * rs * gain[e] * silu_f(z)); }
    }
}
__device__ __forceinline__ void attn_naive_item(const bf16* QKV, bf16* ZYh, const float* subln, float lam, float lam_init, LAS float* sc, int item, int lane) {
    const int h = item & 7, row = item >> 3, i = row & (SEQ - 1), rb = row - i;
    const float slope2 = exp2f(-(float)(h + 1)) * LOG2E;
    const bf16* qp = QKV + (size_t)row * 3072 + h * 128;
    const float q0 = bf2f(qp[lane]), q1 = bf2f(qp[64 + lane]);
    float m0 = -INFINITY, m1 = -INFINITY;
    for (int j0 = 0; j0 <= i; j0 += 64) {
        const int jr = j0 + lane, j = jr <= i ? jr : i;
        const v4u* kp = (const v4u*)(QKV + (size_t)(rb + j) * 3072 + 1024 + h * 128);
        float s0 = 0.f, s1 = 0.f;
#pragma unroll
        for (int c = 0; c < 8; ++c) { const v4u w0 = kp[c], w1 = kp[8 + c];
            s0 += __shfl(q0, 8 * c + 0) * bflo(w0.x) + __shfl(q0, 8 * c + 1) * bfhi(w0.x) + __shfl(q0, 8 * c + 2) * bflo(w0.y) + __shfl(q0, 8 * c + 3) * bfhi(w0.y)
                + __shfl(q0, 8 * c + 4) * bflo(w0.z) + __shfl(q0, 8 * c + 5) * bfhi(w0.z) + __shfl(q0, 8 * c + 6) * bflo(w0.w) + __shfl(q0, 8 * c + 7) * bfhi(w0.w);
            s1 += __shfl(q1, 8 * c + 0) * bflo(w1.x) + __shfl(q1, 8 * c + 1) * bfhi(w1.x) + __shfl(q1, 8 * c + 2) * bflo(w1.y) + __shfl(q1, 8 * c + 3) * bfhi(w1.y)
                + __shfl(q1, 8 * c + 4) * bflo(w1.z) + __shfl(q1, 8 * c + 5) * bfhi(w1.z) + __shfl(q1, 8 * c + 6) * bflo(w1.w) + __shfl(q1, 8 * c + 7) * bfhi(w1.w); }
        const float bias = slope2 * (float)(i - j);
        s0 -= bias; s1 -= bias;
        if (jr <= i) { sc[j] = s0; sc[SEQ + j] = s1; m0 = fmaxf(m0, s0); m1 = fmaxf(m1, s1); }
    }
    m0 = wave_max(m0); m1 = wave_max(m1);
    float l0 = 0.f, l1 = 0.f;
    for (int j = lane; j <= i; j += 64) { const float p0 = exp2f(sc[j] - m0), p1 = exp2f(sc[SEQ + j] - m1); sc[j] = p0; sc[SEQ + j] = p1; l0 += p0; l1 += p1; }
    l0 = wave_sum(l0); l1 = wave_sum(l1);
    LDS_WAIT(); asm volatile("" ::: "memory");
    const float i0 = 1.f / l0, i1 = lam / l1;
    float o0 = 0.f, o1 = 0.f;
    for (int j = 0; j <= i; ++j) {
        const float a = sc[j] * i0 - sc[SEQ + j] * i1;
        const unsigned w = *(const unsigned*)(QKV + (size_t)(rb + j) * 3072 + 2048 + h * 128 + 2 * lane);
        o0 += a * bflo(w); o1 += a * bfhi(w);
    }
    LDS_WAIT(); asm volatile("" ::: "memory");
    const float rs = rsqrtf(wave_sum(o0 * o0 + o1 * o1) * (1.f / 128.f) + EPS) * (1.f - lam_init);
    unsigned* zp = (unsigned*)(ZYh + (size_t)row * 2048 + h * 128 + 2 * lane);
    const unsigned zw = *zp;
    *zp = pk2(o0 * rs * subln[2 * lane] * silu_f(bflo(zw)), o1 * rs * subln[2 * lane + 1] * silu_f(bfhi(zw)));
}

struct Args { const float* in[21]; float* out; unsigned char* ws; };
__global__ void __launch_bounds__(NTHR, 2) mk_fwd(Args args) {
    extern __shared__ __attribute__((aligned(16))) unsigned char lds[];
    Frame F;
    F.lds = (LAS unsigned char*)lds;
    F.tid = threadIdx.x; F.lane = F.tid & 63; F.wave = __builtin_amdgcn_readfirstlane(F.tid >> 6);
    F.G = gridDim.x; { const int bx = blockIdx.x; F.vcu = (F.G % 8 == 0) ? (bx % 8) * (F.G / 8) + bx / 8 : bx; }
    F.gw = F.vcu * NWAVES + F.wave; F.NGW = F.G * NWAVES;
    const CAS unsigned char* kp;
    volatile LAS unsigned* MISC = (volatile LAS unsigned*)(F.lds + MISC_OFF);
    for (int u = F.tid; u < (LDS_BYTES - LDSCTL_OFF) / 4; u += NTHR) ((LAS unsigned*)(F.lds + LDSCTL_OFF))[u] = 0u;
    __syncthreads();
    XcdBarrier bar = xcd_barrier_post((unsigned*)(args.ws + WS_CTL) + CW_BAR, MISC + 8);
#define GRID_BAR() do { XcdBarrier b_ = bar; asm volatile("" : "+s"(b_.bar), "+s"(b_.x)); xcd_barrier(b_); } while (0)

    PHASE_BEGIN();
    { unsigned char* ws = WSP; bf16* H = (bf16*)(ws + WS_H); const float* x = INP(IN_X); const float* pre_g = INP(IN_PREG);
      convert_weights(F, INP(IN_WIN), INP(IN_WOUT), INP(IN_PGATE), INP(IN_PPROJ), ws, 0);
      for (int m = F.gw; m < NTOK; m += F.NGW) rms_row_to_bf16(x + (size_t)m * DM, pre_g, H + (size_t)m * DM, F.lane); }
    GRID_BAR();

#pragma unroll 1
    for (int l = 0; l < 2; ++l) {
        const float lam_init = l == 0 ? 0.2f : 0.35550906f;
#pragma unroll 1
        for (int hb = 0; hb < 2; ++hb) {
            PHASE_BEGIN();
            { unsigned char* ws = WSP; bf16* ZYh = (bf16*)(ws + WS_ZY) + (size_t)hb * HBROWS * 2048;
              pg8::Gemm g{(bf16*)(ws + WS_H) + (size_t)hb * HBROWS * DM, (bf16*)(ws + WS_WIN), HBROWS, NPROJ, DM}; pg8::StaticOrder S; S.init(HBROWS, NPROJ, F.G, F.bx);
              pg8::EpiProj E{(bf16*)(ws + WS_QKV), ZYh, (bf16*)(ws + WS_DNQ), (bf16*)(ws + WS_GLQ), (float*)(ws + WS_SM), 0.125f * LOG2E};
              pg8::gemm_phase<pg8::EpiProj, pg8::StaticOrder, true, true>(F.lds, g, S, E); }
            GRID_BAR();
            PHASE_BEGIN();
            { unsigned char* ws = WSP; const bf16* DNQ = (const bf16*)(ws + WS_DNQ); bf16* DNC = (bf16*)(ws + WS_DNC); const float* SM = (const float*)(ws + WS_SM); float* GK = (float*)(ws + WS_GK);
              const float* convw = INP(IN_DNCONV) + (size_t)l * 4 * 1536; const float* w2 = INP(IN_GW2) + (size_t)l * 16 * 256; const float* gb = INP(IN_GB) + l * 256;
              for (int it = F.gw; it < HBROWS * 12; it += F.NGW) dn_conv_item(DNQ, convw, DNC, it, F.lane);
              for (int it = F.gw; it < HBROWS * 4; it += F.NGW) gla_gk_item(SM, w2, gb, GK, it, F.lane);
              if (hb == 0) { const float* pl = INP(IN_P) + (size_t)l * NTOK * 256; bf16* PBF = (bf16*)(ws + WS_PBF);
                  for (int it = F.gw * 64 + F.lane; it < NTOK * 256 / 4; it += F.NGW * 64) { const f32x4 v = ((const GAS f32x4*)pl)[it]; ((GAS unsigned long long*)PBF)[it] = (unsigned long long)pk2(v.x, v.y) | ((unsigned long long)pk2(v.z, v.w) << 32); } } }
            GRID_BAR();
            PHASE_BEGIN();
            { unsigned char* ws = WSP; bf16* ZYh = (bf16*)(ws + WS_ZY) + (size_t)hb * HBROWS * 2048; const float* SM = (const float*)(ws + WS_SM);
              const int w = F.bx;
              if (w < 8) dn_scan_naive(F, (const bf16*)(ws + WS_DNC), SM, INP(IN_ALOG) + l * 4, INP(IN_DTB) + l * 4, INP(IN_DNNORM) + l * 128, ZYh, 2 * w);
              else if (w < 16) gla_scan_naive(F, (const bf16*)(ws + WS_GLQ), (const float*)(ws + WS_GK), INP(IN_GNORM) + l * 128, ZYh, 2 * (w - 8));
              else {
                  const float la = wave_sum(INP(IN_LQ1)[l * 64 + F.lane] * INP(IN_LK1)[l * 64 + F.lane]), lb = wave_sum(INP(IN_LQ2)[l * 64 + F.lane] * INP(IN_LK2)[l * 64 + F.lane]);
                  const float lam = __expf(la) - __expf(lb) + lam_init;
                  LAS float* sc = (LAS float*)(F.lds + F.wave * 16384);
                  const bf16* QKV = (const bf16*)(ws + WS_QKV); const float* subln = INP(IN_SUBLN) + l * 128;
                  for (int it = (w - 16) * NWAVES + F.wave; it < HBROWS * 8; it += (F.G - 16) * NWAVES) attn_naive_item(QKV, ZYh, subln, lam, lam_init, sc, HBROWS * 8 - 1 - it, F.lane);
              } }
            GRID_BAR();
        }
        PHASE_BEGIN();
        { unsigned char* ws = WSP;
          pg8::Gemm g{(bf16*)(ws + WS_ZY), (bf16*)(ws + WS_WOUT), NTOK, DM, 2048}; pg8::StaticOrder S; S.init(NTOK, DM, F.G, F.bx);
          pg8::EpiF32 E{(float*)(ws + WS_T1), DM};
          pg8::gemm_phase<pg8::EpiF32, pg8::StaticOrder, true, true>(F.lds, g, S, E); }
        PHASE_BEGIN();
        { unsigned char* ws = WSP;
          pg8::Gemm g{(bf16*)(ws + WS_PBF), (bf16*)(ws + WS_WP), NTOK, DM, 256}; pg8::StaticOrder S; S.init(NTOK, DM, F.G, F.bx);
          pg8::EpiBf E{(bf16*)(ws + WS_PP), DM};
          pg8::gemm_phase<pg8::EpiBf, pg8::StaticOrder, true, true>(F.lds, g, S, E); }
        GRID_BAR();
        PHASE_BEGIN();
        { unsigned char* ws = WSP; float* out = OUTP; const float* xin = l == 0 ? INP(IN_X) : (const float*)out; const float* T1 = (const float*)(ws + WS_T1); bf16* XB = (bf16*)(ws + WS_XB); const float* pg = INP(IN_POSTG) + l * DM;
          for (int m = F.gw; m < NTOK; m += F.NGW) norm_res_row(xin + (size_t)m * DM, T1 + (size_t)m * DM, pg, out + (size_t)m * DM, XB + (size_t)m * DM, nullptr, nullptr, F.lane); }
        GRID_BAR();
        PHASE_BEGIN();
        { unsigned char* ws = WSP;
          pg8::Gemm g{(bf16*)(ws + WS_XB), (bf16*)(ws + WS_WG), NTOK, DM, DM}; pg8::StaticOrder S; S.init(NTOK, DM, F.G, F.bx);
          pg8::EpiGate E{(const bf16*)(ws + WS_PP), (float*)(ws + WS_T1), DM};
          pg8::gemm_phase<pg8::EpiGate, pg8::StaticOrder, true, true>(F.lds, g, S, E); }
        GRID_BAR();
        PHASE_BEGIN();
        { unsigned char* ws = WSP; float* out = OUTP; const float* T1 = (const float*)(ws + WS_T1); const float* pn = INP(IN_PNORM) + l * DM;
          if (l == 0) {
            bf16* H = (bf16*)(ws + WS_H); const float* pre1 = INP(IN_PREG) + DM;
            for (int m = F.gw; m < NTOK; m += F.NGW) norm_res_row(out + (size_t)m * DM, T1 + (size_t)m * DM, pn, out + (size_t)m * DM, nullptr, pre1, H + (size_t)m * DM, F.lane);
            convert_weights(F, INP(IN_WIN), INP(IN_WOUT), INP(IN_PGATE), INP(IN_PPROJ), ws, 1);
          } else {
            for (int m = F.gw; m < NTOK; m += F.NGW) norm_res_row(out + (size_t)m * DM, T1 + (size_t)m * DM, pn, out + (size_t)m * DM, nullptr, nullptr, nullptr, F.lane);
          } }
        if (l == 0) GRID_BAR();
    }
}

extern "C" void kernel_launch(void* const* d_in, const int* in_sizes, int n_in, void* d_out, int out_size, void* d_ws, size_t ws_size, hipStream_t stream) {
    static int grid = 0;
    if (grid == 0) {
        if (n_in != 21 || out_size != NTOK * DM || ws_size < WS_END) { fprintf(stderr, "kernel_launch: unexpected shapes (n_in %d out %d ws %zu)\n", n_in, out_size, ws_size); grid = -1; return; }
        int dev = 0, cus = 0;
        if (hipGetDevice(&dev) != hipSuccess || hipDeviceGetAttribute(&cus, hipDeviceAttributeMultiprocessorCount, dev) != hipSuccess) { grid = -1; return; }
        if (hipFuncSetAttribute((const void*)mk_fwd, hipFuncAttributeMaxDynamicSharedMemorySize, LDS_BYTES) != hipSuccess) { fprintf(stderr, "kernel_launch: hipFuncSetAttribute failed\n"); grid = -1; return; }
        int per_cu = 0;
        if (hipOccupancyMaxActiveBlocksPerMultiprocessor(&per_cu, (const void*)mk_fwd, NTHR, LDS_BYTES) != hipSuccess || per_cu < 1) fprintf(stderr, "kernel_launch: occupancy query says %d per CU\n", per_cu);
        (void)hipGetLastError();
        grid = cus;
    }
    if (grid < 0) return;
    if (hipMemsetAsync((char*)d_ws + WS_CTL, 0, CTL_ZERO_BYTES, stream) != hipSuccess) return;
    Args a{};
    for (int i = 0; i < 21; ++i) a.in[i] = (const float*)d_in[i];
    a.out = (float*)d_out; a.ws = (unsigned char*)d_ws;
    hipLaunchKernelGGL(mk_fwd, dim3(grid), dim3(NTHR), LDS_BYTES, stream, a);
}
```

```cpp
#include <hip/hip_runtime.h>
#include <cstdio>
#include <cstdint>
#include <cmath>
namespace pg8 {
#define PG8_LAS __attribute__((address_space(3)))
typedef unsigned short bf16_t;
typedef short bf16x8 __attribute__((ext_vector_type(8)));
typedef float f32x4 __attribute__((ext_vector_type(4)));
typedef unsigned u32x4 __attribute__((ext_vector_type(4)));
constexpr int BM = 256, BK = 64, HALF = 128, HTB = HALF * BK * 2  , STAGE_BYTES = 8 * HTB, NXCD = 8, WGM = 8;

__host__ __device__ __forceinline__ int lds_byte(int r, int c) { const int st = (r >> 4) * 2 + (c >> 5), rr = r & 15, cc = c & 31, ob = rr * 64 + cc * 2; return st * 1024 + (ob ^ (((ob >> 9) & 1) << 5)); }
__host__ __device__ __forceinline__ void stage_rc(int b, int& R, int& C) { const int st = b / 1024, sb = b % 1024, swz = sb ^ (((sb >> 9) & 1) << 5); R = (st >> 1) * 16 + swz / 64; C = (st & 1) * 32 + (swz % 64) / 2; }
__host__ __device__ __forceinline__ int perm32(int rho) { const int n = rho >> 4, i = rho & 15; return 8 * (i >> 2) + 4 * n + (i & 3); }

struct Unit { int pm, pn; };
struct Gemm { const bf16_t* A; const bf16_t* Bt; int M, N, K; };

struct StaticOrder {
    int nM, nN, nwg, G, c;
    __host__ __device__ void init(int M, int N, int G_, int c_) { nM = M / BM; nN = N / BM; nwg = nM * nN; G = G_; c = c_; }
    __host__ __device__ bool next(int i, Unit& u) const {
        const long L = (long)i * G + c; if (L >= nwg) return false;
        int wgid = (int)L; { const int q = nwg / NXCD, r = nwg % NXCD, xcd = wgid % NXCD, off = wgid / NXCD; wgid = (xcd < r ? xcd * (q + 1) : r * (q + 1) + (xcd - r) * q) + off; }
        const int nig = WGM * nN, gid = wgid / nig, fm = gid * WGM, gsz = (nM - fm) < WGM ? (nM - fm) : WGM;
        u.pm = fm + ((wgid % nig) % gsz); u.pn = (wgid % nig) / gsz; return true;
    }
    __device__ __forceinline__ void a_ready(const Unit&) const {}
    __device__ __forceinline__ void done(const Unit&) const {}
};

__device__ __forceinline__ unsigned cvt_pk_bf16(float lo, float hi) { unsigned r; asm volatile("v_cvt_pk_bf16_f32 %0, %1, %2" : "=v"(r) : "v"(lo), "v"(hi)); return r; }
typedef float f32x2 __attribute__((ext_vector_type(2)));
__device__ __forceinline__ float bf_lo(unsigned w) { return __builtin_bit_cast(float, w << 16); }
__device__ __forceinline__ float bf_hi(unsigned w) { return __builtin_bit_cast(float, w & 0xffff0000u); }
#define EPI_IDS() int t_ = threadIdx.x; asm volatile("" : "+v"(t_)); const int wid_ = t_ >> 6, wr = wid_ >> 2, wc = wid_ & 3, fr = t_ & 15, fq = (t_ & 63) >> 4
struct EpiProj {
    static constexpr bool PERM = true, AFTER_DRAIN = false;
    bf16_t* QKV;
    bf16_t* ZY;
    bf16_t* DNQ;
    bf16_t* GLQ;
    float* SM;
    float qscale;
    __device__ __forceinline__ void operator()(const f32x4 (&acc)[2][2][4][2], const Unit& u, int, int, int, int) const {
        EPI_IDS();
        const int pn = u.pn;
        const int row0 = u.pm * BM + wr * 64 + fr;
        if (pn == 30) {
            if (wc == 0) {
#pragma unroll
                for (int ai = 0; ai < 2; ++ai)
#pragma unroll
                    for (int m = 0; m < 4; ++m) { float* d = SM + (size_t)(row0 + ai * HALF + m * 16) * 32 + 8 * fq; *(f32x4*)d = acc[ai][0][m][0]; *(f32x4*)(d + 4) = acc[ai][0][m][1]; }
            }
            return;
        }
        bf16_t* base; int ldc, colt; float sc = 1.f;
        if (pn < 12) { base = QKV; ldc = 3072; colt = pn * 256; if (pn < 4) sc = qscale; }
        else if (pn < 16) { base = ZY; ldc = 2048; colt = (pn - 12) * 256; }
        else if (pn < 22) { base = DNQ; ldc = 1536; colt = (pn - 16) * 256; }
        else if (pn < 24) { base = ZY; ldc = 2048; colt = 1024 + (pn - 22) * 256; }
        else if (pn < 28) { base = GLQ; ldc = 1024; colt = (pn - 24) * 256; }
        else { base = ZY; ldc = 2048; colt = 1536 + (pn - 28) * 256; }
        const int col0 = colt + wc * 32 + 8 * fq;
#pragma unroll
        for (int ai = 0; ai < 2; ++ai)
#pragma unroll
            for (int m = 0; m < 4; ++m) { bf16_t* rowp = base + (size_t)(row0 + ai * HALF + m * 16) * ldc + col0;
#pragma unroll
                for (int bj = 0; bj < 2; ++bj) { const f32x4 v0 = acc[ai][bj][m][0] * sc, v1 = acc[ai][bj][m][1] * sc;
                    u32x4 w; w.x = cvt_pk_bf16(v0[0], v0[1]); w.y = cvt_pk_bf16(v0[2], v0[3]); w.z = cvt_pk_bf16(v1[0], v1[1]); w.w = cvt_pk_bf16(v1[2], v1[3]);
                    *(u32x4*)(rowp + bj * HALF) = w; } }
    }
};
struct EpiBf {
    static constexpr bool PERM = true, AFTER_DRAIN = false;
    bf16_t* O; int ldc;
    __device__ __forceinline__ void operator()(const f32x4 (&acc)[2][2][4][2], const Unit& u, int, int, int, int) const {
        EPI_IDS();
        const int row0 = u.pm * BM + wr * 64 + fr, col0 = u.pn * BM + wc * 32 + 8 * fq;
#pragma unroll
        for (int ai = 0; ai < 2; ++ai)
#pragma unroll
            for (int m = 0; m < 4; ++m) { bf16_t* rowp = O + (size_t)(row0 + ai * HALF + m * 16) * ldc + col0;
#pragma unroll
                for (int bj = 0; bj < 2; ++bj) { const f32x4 v0 = acc[ai][bj][m][0], v1 = acc[ai][bj][m][1];
                    u32x4 w; w.x = cvt_pk_bf16(v0[0], v0[1]); w.y = cvt_pk_bf16(v0[2], v0[3]); w.z = cvt_pk_bf16(v1[0], v1[1]); w.w = cvt_pk_bf16(v1[2], v1[3]);
                    *(u32x4*)(rowp + bj * HALF) = w; } }
    }
};
struct EpiF32 {
    static constexpr bool PERM = true, AFTER_DRAIN = false;
    float* O; int ldc;
    __device__ __forceinline__ void operator()(const f32x4 (&acc)[2][2][4][2], const Unit& u, int, int, int, int) const {
        EPI_IDS();
        const int row0 = u.pm * BM + wr * 64 + fr, col0 = u.pn * BM + wc * 32 + 8 * fq;
#pragma unroll
        for (int ai = 0; ai < 2; ++ai)
#pragma unroll
            for (int m = 0; m < 4; ++m) { float* rowp = O + (size_t)(row0 + ai * HALF + m * 16) * ldc + col0;
#pragma unroll
                for (int bj = 0; bj < 2; ++bj) { *(f32x4*)(rowp + bj * HALF) = acc[ai][bj][m][0]; *(f32x4*)(rowp + bj * HALF + 4) = acc[ai][bj][m][1]; } }
    }
};
struct EpiGate {
    static constexpr bool PERM = true, AFTER_DRAIN = false;
    const bf16_t* PP; float* O; int ldc;
    __device__ __forceinline__ void operator()(const f32x4 (&acc)[2][2][4][2], const Unit& u, int, int, int, int) const {
        EPI_IDS();
        const int row0 = u.pm * BM + wr * 64 + fr, col0 = u.pn * BM + wc * 32 + 8 * fq;
#pragma unroll
        for (int ai = 0; ai < 2; ++ai)
#pragma unroll
            for (int m = 0; m < 4; ++m) { const size_t off = (size_t)(row0 + ai * HALF + m * 16) * ldc + col0;
#pragma unroll
                for (int bj = 0; bj < 2; ++bj) { const u32x4 pw = *(const u32x4*)(PP + off + bj * HALF);
                    const f32x4 a0 = acc[ai][bj][m][0], a1 = acc[ai][bj][m][1];
                    f32x4 o0, o1;
                    o0[0] = bf_lo(pw.x) / (1.f + __expf(-a0[0])); o0[1] = bf_hi(pw.x) / (1.f + __expf(-a0[1]));
                    o0[2] = bf_lo(pw.y) / (1.f + __expf(-a0[2])); o0[3] = bf_hi(pw.y) / (1.f + __expf(-a0[3]));
                    o1[0] = bf_lo(pw.z) / (1.f + __expf(-a1[0])); o1[1] = bf_hi(pw.z) / (1.f + __expf(-a1[1]));
                    o1[2] = bf_lo(pw.w) / (1.f + __expf(-a1[2])); o1[3] = bf_hi(pw.w) / (1.f + __expf(-a1[3]));
                    *(f32x4*)(O + off + bj * HALF) = o0; *(f32x4*)(O + off + bj * HALF + 4) = o1; } }
    }
};
template <class Epi, class Sched, bool ALIGN_EPI = false, bool SP2 = false>
__device__ __forceinline__ void gemm_phase(PG8_LAS unsigned char* lds, const Gemm g, const Sched& S, const Epi& E) {
    int tid_ = threadIdx.x; asm volatile("" : "+v"(tid_));
    const int tid = tid_, wid = __builtin_amdgcn_readfirstlane(tid >> 6), lane = tid & 63, wr = wid >> 2, wc = wid & 3, fr = lane & 15, fq = lane >> 4;
    const int K = g.K, nt = K / BK;
    unsigned voffA[2], voffB[2];
#pragma unroll
    for (int i = 0; i < 2; ++i) { int R, C; stage_rc(tid * 16 + i * 8192, R, C); const int Rb = Epi::PERM ? ((R & ~31) + perm32(R & 31)) : R;
        voffA[i] = (unsigned)(R * K + C) * 2u; voffB[i] = (unsigned)(Rb * K + C) * 2u; }
    const size_t kstep = (size_t)(BK * 2);
    const size_t hstep = (size_t)HALF * K * 2;
    const size_t tstep = 2 * hstep;
    const unsigned ldsw = (unsigned)wid * 1024u;
    const int aoff = lds_byte(wr * 64 + fr, fq * 8), boff = lds_byte(wc * 32 + fr, fq * 8);
#define PG8_SA(b, h) (((b) * 2 + (h)) * HTB)
#define PG8_SB(b, h) ((4 + (b) * 2 + (h)) * HTB)
#define PG8_STAGE(bufoff, gbase, voff) do { _Pragma("unroll") for (int _i = 0; _i < 2; ++_i) \
        __builtin_amdgcn_global_load_lds((const unsigned*)((const char*)(gbase) + (voff)[_i]), (PG8_LAS unsigned*)(lds + (bufoff) + ldsw + _i * 8192), 16, 0, 0); } while (0)
#define PG8_LDA(dst, b, h) do { _Pragma("unroll") for (int m = 0; m < 4; ++m) _Pragma("unroll") for (int k = 0; k < 2; ++k) dst[m][k] = *(const PG8_LAS bf16x8*)(lds + PG8_SA(b, h) + aoff + m * 2048 + k * 1024); } while (0)
#define PG8_LDB(dst, b, h) do { _Pragma("unroll") for (int n = 0; n < 2; ++n) _Pragma("unroll") for (int k = 0; k < 2; ++k) dst[n][k] = *(const PG8_LAS bf16x8*)(lds + PG8_SB(b, h) + boff + n * 2048 + k * 1024); } while (0)
#define PG8_MMA(ai, bj, At, Bt) do { __builtin_amdgcn_s_setprio(1); _Pragma("unroll") for (int m = 0; m < 4; ++m) _Pragma("unroll") for (int n = 0; n < 2; ++n) _Pragma("unroll") for (int k = 0; k < 2; ++k) \
        acc[ai][bj][m][n] = __builtin_amdgcn_mfma_f32_16x16x32_bf16(Bt[n][k], At[m][k], acc[ai][bj][m][n], 0, 0, 0); __builtin_amdgcn_s_setprio(0); } while (0)
#define PG8_WAIT_V(n) asm volatile("s_waitcnt vmcnt(" #n ")" ::: "memory")
#define PG8_WAIT_L(n) asm volatile("s_waitcnt lgkmcnt(" #n ")" ::: "memory")
#define PG8_BAR __builtin_amdgcn_s_barrier()
#define PG8_SCHED __builtin_amdgcn_sched_barrier(0)
    Unit cur, nxt; int ui = 0;
    if (!S.next(0, cur)) return;
    f32x4 acc[2][2][4][2];
#pragma unroll
    for (int a = 0; a < 2; ++a)
#pragma unroll
        for (int b = 0; b < 2; ++b)
#pragma unroll
            for (int m = 0; m < 4; ++m)
#pragma unroll
                for (int n = 0; n < 2; ++n) acc[a][b][m][n] = (f32x4){0.f, 0.f, 0.f, 0.f};
    bf16x8 At[4][2], B0[2][2], B1[2][2];
    const char* cA = (const char*)g.A + (size_t)cur.pm * tstep; const char* cB = (const char*)g.Bt + (size_t)cur.pn * tstep;
    S.a_ready(cur);
    if constexpr (SP2) {
        PG8_STAGE(PG8_SB(0, 0), cB, voffB); PG8_STAGE(PG8_SB(0, 1), cB + hstep, voffB); PG8_STAGE(PG8_SA(0, 0), cA, voffA); PG8_STAGE(PG8_SA(0, 1), cA + hstep, voffA);
        if (wr == 1) PG8_BAR;
        PG8_WAIT_V(2); PG8_BAR;
        PG8_STAGE(PG8_SB(1, 0), cB + kstep, voffB); PG8_STAGE(PG8_SA(1, 0), cA + kstep, voffA); PG8_STAGE(PG8_SB(1, 1), cB + hstep + kstep, voffB);
        PG8_WAIT_V(6); PG8_BAR;
    } else {
        PG8_STAGE(PG8_SB(0, 0), cB, voffB); PG8_STAGE(PG8_SA(0, 0), cA, voffA); PG8_STAGE(PG8_SB(0, 1), cB + hstep, voffB); PG8_STAGE(PG8_SA(0, 1), cA + hstep, voffA);
        if (wr == 1) PG8_BAR;
        PG8_WAIT_V(4); PG8_BAR;
        PG8_STAGE(PG8_SB(1, 0), cB + kstep, voffB); PG8_STAGE(PG8_SA(1, 0), cA + kstep, voffA); PG8_STAGE(PG8_SB(1, 1), cB + hstep + kstep, voffB);
        PG8_WAIT_V(6); PG8_BAR;
    }
    for (;;) {
        const bool has_next = S.next(ui + 1, nxt);
        const char* nA = has_next ? (const char*)g.A + (size_t)nxt.pm * tstep : cA; const char* nB = has_next ? (const char*)g.Bt + (size_t)nxt.pn * tstep : cB;
        for (int t = 0; t < nt; t += 2) {
            const bool last = (t == nt - 2);
            const char* a1 = cA + (size_t)(t + 1) * kstep;
            const char* a2 = last ? nA : cA + (size_t)(t + 2) * kstep; const char* b2 = last ? nB : cB + (size_t)(t + 2) * kstep;
            const char* a3 = a2 + kstep; const char* b3 = b2 + kstep;
            if (last && has_next) S.a_ready(nxt);
            if constexpr (SP2) {
            PG8_LDB(B0, 0, 0); PG8_LDB(B1, 0, 1); PG8_SCHED; PG8_LDA(At, 0, 0); PG8_STAGE(PG8_SA(1, 1), a1 + hstep, voffA);
            PG8_WAIT_V(8); PG8_WAIT_L(0); PG8_BAR; PG8_MMA(0, 0, At, B0); PG8_MMA(0, 1, At, B1); PG8_BAR; PG8_SCHED;
            PG8_LDA(At, 0, 1); PG8_STAGE(PG8_SB(0, 0), b2, voffB); PG8_STAGE(PG8_SB(0, 1), b2 + hstep, voffB); PG8_STAGE(PG8_SA(0, 0), a2, voffA);
            PG8_WAIT_V(8); PG8_WAIT_L(0); PG8_BAR; PG8_MMA(1, 0, At, B0); PG8_MMA(1, 1, At, B1); PG8_BAR; PG8_SCHED;
            PG8_LDB(B0, 1, 0); PG8_LDB(B1, 1, 1); PG8_SCHED; PG8_LDA(At, 1, 0); PG8_STAGE(PG8_SA(0, 1), a2 + hstep, voffA);
            PG8_WAIT_V(8); PG8_WAIT_L(0); PG8_BAR; PG8_MMA(0, 0, At, B0); PG8_MMA(0, 1, At, B1); PG8_BAR; PG8_SCHED;
            PG8_LDA(At, 1, 1); PG8_STAGE(PG8_SB(1, 0), b3, voffB); PG8_STAGE(PG8_SB(1, 1), b3 + hstep, voffB); PG8_STAGE(PG8_SA(1, 0), a3, voffA);
            PG8_WAIT_V(8); PG8_WAIT_L(0); PG8_BAR; PG8_MMA(1, 0, At, B0); PG8_MMA(1, 1, At, B1); PG8_BAR; PG8_SCHED;
            } else {
            PG8_LDB(B0, 0, 0); PG8_SCHED; PG8_LDA(At, 0, 0); PG8_STAGE(PG8_SA(1, 1), a1 + hstep, voffA);
            PG8_WAIT_L(8); PG8_BAR; PG8_WAIT_L(0); PG8_MMA(0, 0, At, B0); PG8_BAR; PG8_SCHED;
            PG8_LDB(B1, 0, 1); PG8_STAGE(PG8_SB(0, 0), b2, voffB);
            PG8_BAR; PG8_WAIT_L(0); PG8_MMA(0, 1, At, B1); PG8_BAR;
            PG8_LDA(At, 0, 1); PG8_STAGE(PG8_SA(0, 0), a2, voffA);
            PG8_BAR; PG8_WAIT_L(0); PG8_MMA(1, 0, At, B0); PG8_BAR; PG8_SCHED;
            PG8_STAGE(PG8_SB(0, 1), b2 + hstep, voffB);
            PG8_WAIT_V(6); PG8_BAR; PG8_MMA(1, 1, At, B1); PG8_BAR;
            PG8_LDB(B0, 1, 0); PG8_SCHED; PG8_LDA(At, 1, 0); PG8_STAGE(PG8_SA(0, 1), a2 + hstep, voffA);
            PG8_WAIT_L(8); PG8_BAR; PG8_WAIT_L(0); PG8_MMA(0, 0, At, B0); PG8_BAR; PG8_SCHED;
            PG8_LDB(B1, 1, 1); PG8_STAGE(PG8_SB(1, 0), b3, voffB);
            PG8_BAR; PG8_WAIT_L(0); PG8_MMA(0, 1, At, B1); PG8_BAR;
            PG8_LDA(At, 1, 1); PG8_STAGE(PG8_SA(1, 0), a3, voffA);
            PG8_BAR; PG8_WAIT_L(0); PG8_MMA(1, 0, At, B0); PG8_BAR; PG8_SCHED;
            PG8_STAGE(PG8_SB(1, 1), b3 + hstep, voffB);
            PG8_WAIT_V(6); PG8_BAR; PG8_MMA(1, 1, At, B1); PG8_BAR;
            }
        }
        if constexpr (ALIGN_EPI) { if (wr == 0) PG8_BAR; }
        if constexpr (!Epi::AFTER_DRAIN) { E(acc, cur, wr, wc, fr, fq); S.done(cur); }
        if (!has_next) break;
#pragma unroll
        for (int a = 0; a < 2; ++a)
#pragma unroll
            for (int b = 0; b < 2; ++b)
#pragma unroll
                for (int m = 0; m < 4; ++m)
#pragma unroll
                    for (int n = 0; n < 2; ++n) acc[a][b][m][n] = (f32x4){0.f, 0.f, 0.f, 0.f};
        cur = nxt; cA = nA; cB = nB; ++ui;
        if constexpr (ALIGN_EPI) { if (wr == 1) PG8_BAR; }
    }
    PG8_WAIT_V(0);
    if constexpr (!ALIGN_EPI) { if (wr == 0) PG8_BAR; }
    PG8_BAR;
    if constexpr (Epi::AFTER_DRAIN) { E.fused(acc, cur, wr, wc, fr, fq, lds, wid, lane); S.done(cur); }
#undef PG8_SA
#undef PG8_SB
#undef PG8_STAGE
#undef PG8_LDA
#undef PG8_LDB
#undef PG8_MMA
#undef PG8_WAIT_V
#undef PG8_WAIT_L
#undef PG8_BAR
#undef PG8_SCHED
}
}
#define GAS __attribute__((address_space(1)))
#define LAS __attribute__((address_space(3)))
typedef unsigned short bf16;
typedef unsigned v4u __attribute__((ext_vector_type(4)));
typedef float f32x4 __attribute__((ext_vector_type(4)));
typedef short bf16x8 __attribute__((ext_vector_type(8)));
typedef GAS unsigned gu32;
typedef GAS unsigned long long gu64;
#define RLX_AGENT __ATOMIC_RELAXED, __HIP_MEMORY_SCOPE_AGENT
#define LDS_WAIT() asm volatile("s_waitcnt lgkmcnt(0)" ::: "memory")
#define VM_WAIT() asm volatile("s_waitcnt vmcnt(0)" ::: "memory")
__device__ __forceinline__ unsigned long long rt() { return __builtin_amdgcn_s_memrealtime(); }
__device__ __forceinline__ unsigned f2bf(float f) { unsigned u = __builtin_bit_cast(unsigned, f); return (u + 0x7fffu + ((u >> 16) & 1u)) >> 16; }
__device__ __forceinline__ unsigned pk2(float lo, float hi) { return f2bf(lo) | (f2bf(hi) << 16); }

#define XB_TMO      128
#define XB_XCNT(j)  (256  + 64 * (j))
#define XB_XSUB(j)  (1280 + 64 * (j))
#define XB_XGEN(j)  (2304 + 64 * (j))
#define XB_TOP      3328
#define XB_TOPGEN   3392
#define XCD_BAR_WORDS 3456
#define XB_SPIN_CAP (1u << 18)

__device__ __forceinline__ unsigned xb_ld(unsigned* p)              { return __hip_atomic_load(p, __ATOMIC_RELAXED, __HIP_MEMORY_SCOPE_AGENT); }
__device__ __forceinline__ unsigned xb_add(unsigned* p, unsigned v) { return __hip_atomic_fetch_add(p, v, __ATOMIC_RELAXED, __HIP_MEMORY_SCOPE_AGENT); }
__device__ __forceinline__ unsigned xb_xcc_id() { return (unsigned)__builtin_amdgcn_s_getreg((3 << 11) | 20) & 0xFu; }
#define XB_SPIN(cond, bar) do { unsigned _sp = 0; while (cond) { __builtin_amdgcn_s_sleep(1); \
    if ((++_sp & 255u) == 0u) { if (xb_ld(&(bar)[XB_TMO])) break; if (_sp > XB_SPIN_CAP) { atomicAdd(&(bar)[XB_TMO], 1u); break; } } } } while (0)

struct XcdBarrier {
    unsigned* bar; unsigned x;
    volatile LAS unsigned* st;
};

__device__ __forceinline__ XcdBarrier xcd_barrier_post(unsigned* bar, volatile LAS unsigned* st) {
    XcdBarrier b; b.bar = bar; b.x = xb_xcc_id(); b.st = st;
    if (threadIdx.x == 0) (void)xb_add(&bar[XB_XCNT(b.x)], 1u);
    return b;
}
__device__ __forceinline__ void xcd_barrier_complete(unsigned* bar, unsigned x, unsigned& nloc, unsigned& nx) {
    const unsigned G = gridDim.x * gridDim.y * gridDim.z;
    unsigned sum, cnt, mine, sp = 0u;
    for (;;) {
        sum = 0u; cnt = 0u; mine = 0u;
#pragma unroll
        for (unsigned j = 0; j < 16; ++j) { const unsigned c = xb_ld(&bar[XB_XCNT(j)]); sum += c; cnt += (c > 0u) ? 1u : 0u; mine = (j == x) ? c : mine; }
        if (sum == G) break;
        __builtin_amdgcn_s_sleep(1);
        if ((++sp & 255u) == 0u) { if (xb_ld(&bar[XB_TMO])) break; if (sp > XB_SPIN_CAP) { atomicAdd(&bar[XB_TMO], 1u); break; } }
    }
    nloc = mine > 0u ? mine : 1u; nx = cnt > 0u ? cnt : 1u;
}

__device__ __forceinline__ void xcd_barrier(const XcdBarrier& b) {
    asm volatile("s_waitcnt vmcnt(0)" ::: "memory");
    __syncthreads();
    if (threadIdx.x == 0) {
        unsigned* bar = b.bar;
        __builtin_amdgcn_s_waitcnt(0);
        unsigned nloc = b.st[0], nx = b.st[1];
        if (nloc == 0u) { xcd_barrier_complete(bar, b.x, nloc, nx); b.st[0] = nloc; b.st[1] = nx; }
        const unsigned old = xb_add(&bar[XB_XSUB(b.x)], 1u);
        const unsigned gen = old / nloc;
        if (old + 1u == (gen + 1u) * nloc) {
            __builtin_amdgcn_fence(__ATOMIC_RELEASE, "agent");
            asm volatile("s_waitcnt vmcnt(0)" ::: "memory");
            const unsigned og = xb_add(&bar[XB_TOP], 1u);
            const unsigned tg = og / nx;
            if (og + 1u == (tg + 1u) * nx) xb_add(&bar[XB_TOPGEN], 1u);
            else XB_SPIN(xb_ld(&bar[XB_TOPGEN]) == tg, bar);
            __builtin_amdgcn_fence(__ATOMIC_ACQUIRE, "agent");
            xb_add(&bar[XB_XGEN(b.x)], 1u);
            asm volatile("s_waitcnt vmcnt(0)" ::: "memory");
        } else {
            XB_SPIN(xb_ld(&bar[XB_XGEN(b.x)]) == gen, bar);
            __builtin_amdgcn_fence(__ATOMIC_ACQUIRE, "agent");
            asm volatile("s_waitcnt vmcnt(0)" ::: "memory");
        }
    }
    __syncthreads();
}

constexpr int NWAVES = 8, NTHR = 512;
constexpr int SEQ = 2048, DM = 1024, NTOK = 16384, HBROWS = 8192;
constexpr int D_IN = 7704, NPROJ = 7936;
constexpr float EPS = 1e-6f;
constexpr float LOG2E = 1.4426950408889634f;
constexpr int C_DB = 6144, C_GQ = 6152, C_GR = 7688;
constexpr size_t MiB = 1u << 20;
constexpr size_t WS_CTL = 0, CTL_ZERO_BYTES = 65536;
constexpr size_t WS_WIN = 1 * MiB, WS_WOUT = 17 * MiB, WS_WG = 21 * MiB, WS_WP = 23 * MiB;
constexpr size_t WS_H = 24 * MiB, WS_ZY = 56 * MiB;
constexpr size_t WS_QKV = 120 * MiB, WS_DNQ = 168 * MiB, WS_GLQ = 192 * MiB, WS_SM = 208 * MiB, WS_DNC = 209 * MiB, WS_GK = 233 * MiB;
constexpr size_t WS_T1 = 120 * MiB, WS_PP = 184 * MiB, WS_XB = 216 * MiB, WS_PBF = 248 * MiB, WS_END = 256 * MiB;
constexpr int CW_BAR = 1024, CW_Q = 256;
static_assert((CW_BAR + XCD_BAR_WORDS) * 4 <= (int)CTL_ZERO_BYTES, "ctl");
constexpr int RING_BYTES = 131072, LDSCTL_OFF = RING_BYTES, MISC_OFF = LDSCTL_OFF + 320, LDS_BYTES = 147456;

__device__ __forceinline__ float bperm_xor(float v, int lane, int o) { return __builtin_bit_cast(float, __builtin_amdgcn_ds_bpermute((lane ^ o) << 2, __builtin_bit_cast(int, v))); }
__device__ __forceinline__ float wave_sum(float v, int lane) {
#pragma unroll
    for (int o = 1; o < 64; o <<= 1) v += bperm_xor(v, lane, o);
    return v;
}
__device__ __forceinline__ float silu_f(float x) { return x / (1.f + __expf(-x)); }
__device__ __forceinline__ float sigmoid_f(float x) { return 1.f / (1.f + __expf(-x)); }
__device__ __forceinline__ float softplus_f(float x) { return fmaxf(x, 0.f) + log1pf(__expf(-fabsf(x))); }
__device__ __forceinline__ float bflo(unsigned w) { return __builtin_bit_cast(float, w << 16); }
__device__ __forceinline__ float bfhi(unsigned w) { return __builtin_bit_cast(float, w & 0xffff0000u); }
__device__ __forceinline__ float bf2f(bf16 h) { return __builtin_bit_cast(float, (unsigned)h << 16); }

struct Frame {
    LAS unsigned char* lds;
    int tid, lane, wave, vcu, G, gw, NGW, bx;
};
#define CAS __attribute__((address_space(4)))
#define PHASE_BEGIN() do { int t_ = threadIdx.x; asm volatile("" : "+v"(t_)); F.tid = t_; F.lane = t_ & 63; F.wave = __builtin_amdgcn_readfirstlane(t_ >> 6); \
    { int bx_ = blockIdx.x; asm volatile("" : "+s"(bx_)); F.vcu = (bx_ % 8) * (F.G / 8) + bx_ / 8; F.bx = bx_; } F.gw = F.vcu * NWAVES + F.wave; kp = (const CAS unsigned char*)__builtin_amdgcn_kernarg_segment_ptr(); asm volatile("" : "+s"(kp)); } while (0)
#define INP(k) (((const float* const CAS*)kp)[k])
#define OUTP   (((float* const CAS*)kp)[21])
#define WSP    (((unsigned char* const CAS*)kp)[22])
enum { IN_X = 0, IN_P, IN_WIN, IN_WOUT, IN_PREG, IN_POSTG, IN_LQ1, IN_LK1, IN_LQ2, IN_LK2, IN_SUBLN, IN_DNCONV, IN_ALOG, IN_DTB, IN_DNNORM, IN_GW2, IN_GB, IN_GNORM, IN_PPROJ, IN_PGATE, IN_PNORM };

__device__ __forceinline__ void transpose_item(const float* W, int ldw, int src0, bf16* WT, int K, int dst0, int nblk, LAS float* scr, int item, int lane) {
    const int kb = item / nblk, nb = item % nblk, k0 = 64 * kb, n0 = 32 * nb;
#pragma unroll 8
    for (int i = 0; i < 32; ++i) { const int kk = 2 * i + (lane >> 5); scr[kk * 33 + (lane & 31)] = W[(size_t)(k0 + kk) * ldw + src0 + n0 + (lane & 31)]; }
    LDS_WAIT(); asm volatile("" ::: "memory");
    const int c = lane & 7;
#pragma unroll
    for (int j = 0; j < 4; ++j) { const int n = (lane >> 3) + 8 * j; const LAS float* s = scr + (8 * c) * 33 + n;
        v4u o; o.x = pk2(s[0 * 33], s[1 * 33]); o.y = pk2(s[2 * 33], s[3 * 33]); o.z = pk2(s[4 * 33], s[5 * 33]); o.w = pk2(s[6 * 33], s[7 * 33]);
        *(GAS v4u*)(WT + (size_t)(dst0 + n0 + n) * K + k0 + 8 * c) = o; }
    LDS_WAIT(); asm volatile("" ::: "memory");
}
__device__ __forceinline__ void convert_weights(const Frame& F, const float* w_in0, const float* w_out0, const float* wg0, const float* wp0, unsigned char* ws, int l) {
    LAS float* scr = (LAS float*)(F.lds + F.wave * 16384);
    const float* w_in = w_in0 + (size_t)l * 1024 * D_IN; const float* w_out = w_out0 + (size_t)l * 2048 * 1024;
    const float* wg = wg0 + (size_t)l * 1024 * 1024; const float* wp = wp0 + (size_t)l * 256 * 1024;
    bf16* WIN = (bf16*)(ws + WS_WIN); bf16* WOUT = (bf16*)(ws + WS_WOUT); bf16* WG = (bf16*)(ws + WS_WG); bf16* WP = (bf16*)(ws + WS_WP);
    constexpr int I_A = 16 * 192, I_B = 16 * 48, I_O = 32 * 32, I_G = 16 * 32, I_P = 4 * 32, I_S = 256;
    constexpr int NIT = I_A + I_B + I_O + I_G + I_P + I_S;
    for (int it = F.gw; it < NIT; it += F.NGW) {
        int r = it;
        if (r < I_A) { transpose_item(w_in, D_IN, 0, WIN, 1024, 0, 192, scr, r, F.lane); continue; } r -= I_A;
        if (r < I_B) { transpose_item(w_in, D_IN, C_GQ, WIN, 1024, 6144, 48, scr, r, F.lane); continue; } r -= I_B;
        if (r < I_O) { transpose_item(w_out, 1024, 0, WOUT, 2048, 0, 32, scr, r, F.lane); continue; } r -= I_O;
        if (r < I_G) { transpose_item(wg, 1024, 0, WG, 1024, 0, 32, scr, r, F.lane); continue; } r -= I_G;
        if (r < I_P) { transpose_item(wp, 1024, 0, WP, 256, 0, 32, scr, r, F.lane); continue; } r -= I_P;
        const int src = r < 8 ? C_DB + r : (r < 24 ? C_GR + (r - 8) : -1);
#pragma unroll 4
        for (int j = 0; j < 16; ++j) { const int k = F.lane + 64 * j; const float v = src >= 0 ? w_in[(size_t)k * D_IN + src] : 0.f; WIN[(size_t)(7680 + r) * 1024 + k] = (bf16)f2bf(v); }
    }
}
__device__ __forceinline__ void rms_row_to_bf16(const float* xrow, const float* g, bf16* orow, int lane) {
    const GAS f32x4* xr = (const GAS f32x4*)xrow + lane; const GAS f32x4* gr = (const GAS f32x4*)g + lane;
    f32x4 v[4]; float s = 0.f;
#pragma unroll
    for (int j = 0; j < 4; ++j) { v[j] = xr[64 * j]; s += (v[j].x * v[j].x + v[j].y * v[j].y) + (v[j].z * v[j].z + v[j].w * v[j].w); }
    const float rs = rsqrtf(wave_sum(s, lane) * (1.f / 1024.f) + EPS);
    GAS unsigned long long* o8 = (GAS unsigned long long*)orow + lane;
#pragma unroll
    for (int j = 0; j < 4; ++j) { const f32x4 gg = gr[64 * j]; o8[64 * j] = (unsigned long long)pk2(v[j].x * rs * gg.x, v[j].y * rs * gg.y) | ((unsigned long long)pk2(v[j].z * rs * gg.z, v[j].w * rs * gg.w) << 32); }
}
__device__ __forceinline__ void norm_res_row(const float* xi, const float* t, const float* g, float* xo, bf16* xb, const float* g2, bf16* hn, int lane) {
    const GAS f32x4* tr = (const GAS f32x4*)t + lane; const GAS f32x4* gr = (const GAS f32x4*)g + lane; const GAS f32x4* xr = (const GAS f32x4*)xi + lane;
    f32x4 v[4]; float s = 0.f;
#pragma unroll
    for (int j = 0; j < 4; ++j) { v[j] = tr[64 * j]; s += (v[j].x * v[j].x + v[j].y * v[j].y) + (v[j].z * v[j].z + v[j].w * v[j].w); }
    const float rs = rsqrtf(wave_sum(s, lane) * (1.f / 1024.f) + EPS);
    float s2 = 0.f;
#pragma unroll
    for (int j = 0; j < 4; ++j) { const f32x4 gg = gr[64 * j]; const f32x4 xx = xr[64 * j]; v[j] = xx + v[j] * rs * gg; s2 += (v[j].x * v[j].x + v[j].y * v[j].y) + (v[j].z * v[j].z + v[j].w * v[j].w);
        ((GAS f32x4*)xo + lane)[64 * j] = v[j]; }
    if (xb) { GAS unsigned long long* o8 = (GAS unsigned long long*)xb + lane;
#pragma unroll
        for (int j = 0; j < 4; ++j) o8[64 * j] = (unsigned long long)pk2(v[j].x, v[j].y) | ((unsigned long long)pk2(v[j].z, v[j].w) << 32); }
    if (hn) { const float rs2 = rsqrtf(wave_sum(s2, lane) * (1.f / 1024.f) + EPS); const GAS f32x4* g2r = (const GAS f32x4*)g2 + lane; GAS unsigned long long* o8 = (GAS unsigned long long*)hn + lane;
#pragma unroll
        for (int j = 0; j < 4; ++j) { const f32x4 gg = g2r[64 * j]; o8[64 * j] = (unsigned long long)pk2(v[j].x * rs2 * gg.x, v[j].y * rs2 * gg.y) | ((unsigned long long)pk2(v[j].z * rs2 * gg.z, v[j].w * rs2 * gg.w) << 32); } }
}

__device__ __forceinline__ void dn_conv_item(const bf16* DNQ, const float* convw, bf16* DNC, int item, int lane) {
    const int g = item % 12, row = item / 12, t = row & (SEQ - 1);
    const int c = g * 128 + 2 * lane;
    float a0 = 0.f, a1 = 0.f;
#pragma unroll
    for (int j = 0; j < 4; ++j) { const int tt = t - 3 + j; if (tt >= 0) { const unsigned w = *(const unsigned*)(DNQ + (size_t)(row - 3 + j) * 1536 + c); a0 += convw[j * 1536 + c] * bflo(w); a1 += convw[j * 1536 + c + 1] * bfhi(w); } }
    float y0 = silu_f(a0), y1 = silu_f(a1);
    if (g < 8) { float rs = rsqrtf(wave_sum(y0 * y0 + y1 * y1, lane) + EPS); if (g < 4) rs *= 0.08838834764831845f; y0 *= rs; y1 *= rs; }
    *(unsigned*)(DNC + (size_t)row * 1536 + c) = pk2(y0, y1);
}
__device__ __forceinline__ void gla_gk_item(const float* SM, const float* w2, const float* bias, float* GK, int item, int lane) {
    const int row = item >> 2, c = (item & 3) * 64 + lane;
    float a = bias[c];
#pragma unroll
    for (int r = 0; r < 16; ++r) a += SM[(size_t)row * 32 + 8 + r] * w2[r * 256 + c];
    const float ls = fminf(a, 0.f) - log1pf(__expf(-fabsf(a)));
    GK[(size_t)row * 256 + c] = ls * (1.f / 16.f);
}
__device__ __forceinline__ void dn_scan_naive(const Frame& F, const bf16* DNC, const float* SM, const float* a_log, const float* dt_bias, const float* gain, bf16* ZYh, int unit) {
    LAS float* kq = (LAS float*)(F.lds);
    LAS float* part = (LAS float*)(F.lds + 4096);
    LAS float* ssp = (LAS float*)(F.lds + 8192);
    const int sub = F.tid >> 8, tl = F.tid & 255, e = tl & 127, half = tl >> 7;
    const int u = unit + sub, bl = u >> 2, h = u & 3;
    float S[64];
#pragma unroll
    for (int d = 0; d < 64; ++d) S[d] = 0.f;
    const float A = -__expf(a_log[h]); const float dtb = dt_bias[h];
    for (int t = 0; t < SEQ; ++t) {
        const int row = bl * SEQ + t, bf = t & 1;
        const bf16* dr = DNC + (size_t)row * 1536;
        kq[(sub * 2 + bf) * 256 + tl] = (tl < 128) ? bf2f(dr[512 + h * 128 + tl]) : bf2f(dr[h * 128 + (tl - 128)]);
        const float v = bf2f(dr[1024 + h * 128 + e]);
        const float beta = sigmoid_f(SM[(size_t)row * 32 + h]);
        const float a = __expf(A * softplus_f(SM[(size_t)row * 32 + 4 + h] + dtb));
        __syncthreads();
        const LAS float* kk = kq + (sub * 2 + bf) * 256 + half * 64; const LAS float* qq = kk + 128;
        float r = 0.f;
#pragma unroll
        for (int d = 0; d < 64; ++d) r += S[d] * kk[d];
        part[((sub * 2 + bf) * 2 + half) * 128 + e] = r;
        __syncthreads();
        const float rr = part[((sub * 2 + bf) * 2 + 0) * 128 + e] + part[((sub * 2 + bf) * 2 + 1) * 128 + e];
        const float vnew = beta * (v - a * rr);
        float o = 0.f;
#pragma unroll
        for (int d = 0; d < 64; ++d) { S[d] = a * S[d] + kk[d] * vnew; o += S[d] * qq[d]; }
        __syncthreads();
        part[((sub * 2 + bf) * 2 + half) * 128 + e] = o;
        __syncthreads();
        float ot = 0.f;
        if (half == 0) { ot = part[((sub * 2 + bf) * 2 + 0) * 128 + e] + part[((sub * 2 + bf) * 2 + 1) * 128 + e]; const float ss = wave_sum(ot * ot, tl & 63); if ((tl & 63) == 0) ssp[(sub * 2 + bf) * 2 + (tl >> 6)] = ss; }
        __syncthreads();
        if (half == 0) { const float rs = rsqrtf((ssp[(sub * 2 + bf) * 2] + ssp[(sub * 2 + bf) * 2 + 1]) * (1.f / 128.f) + EPS);
            bf16* zp = ZYh + (size_t)row * 2048 + 1024 + h * 128 + e; const float z = bf2f(*zp); *zp = (bf16)f2bf(ot * rs * gain[e] * silu_f(z)); }
    }
}
__device__ __forceinline__ void gla_scan_naive(const Frame& F, const bf16* GLQ, const float* GK, const float* gain, bf16* ZYh, int unit) {
    LAS float* qa = (LAS float*)(F.lds);
    LAS float* part = (LAS float*)(F.lds + 4096);
    LAS float* ssp = (LAS float*)(F.lds + 8192);
    const int sub = F.tid >> 8, tl = F.tid & 255, e = tl & 127, half = tl >> 7;
    const int u = unit + sub, bl = u >> 2, h = u & 3;
    float S[32];
#pragma unroll
    for (int d = 0; d < 32; ++d) S[d] = 0.f;
    for (int t = 0; t < SEQ; ++t) {
        const int row = bl * SEQ + t, bf = t & 1;
        const bf16* gr = GLQ + (size_t)row * 1024;
        LAS float* q3 = qa + (sub * 2 + bf) * 192;
        if (tl < 64) q3[tl] = __expf(GK[(size_t)row * 256 + h * 64 + tl]);
        else if (tl < 128) q3[tl] = bf2f(gr[256 + h * 64 + tl - 64]);
        else if (tl < 192) q3[tl] = bf2f(gr[h * 64 + tl - 128]) * 0.125f;
        const float v = bf2f(gr[512 + h * 128 + e]);
        __syncthreads();
        float o = 0.f;
#pragma unroll
        for (int d = 0; d < 32; ++d) { const int dd = half * 32 + d; S[d] = q3[dd] * S[d] + q3[64 + dd] * v; o += q3[128 + dd] * S[d]; }
        part[((sub * 2 + bf) * 2 + half) * 128 + e] = o;
        __syncthreads();
        float ot = 0.f;
        if (half == 0) { ot = part[((sub * 2 + bf) * 2 + 0) * 128 + e] + part[((sub * 2 + bf) * 2 + 1) * 128 + e]; const float ss = wave_sum(ot * ot, tl & 63); if ((tl & 63) == 0) ssp[(sub * 2 + bf) * 2 + (tl >> 6)] = ss; }
        __syncthreads();
        if (half == 0) { const float rs = rsqrtf((ssp[(sub * 2 + bf) * 2] + ssp[(sub * 2 + bf) * 2 + 1]) * (1.f / 128.f) + EPS);
            bf16* zp = ZYh + (size_t)row * 2048 + 1536 + h * 128 + e; const float z = bf2f(*zp); *zp = (bf16)f2bf(ot * rs * gain[e] * silu_f(z)); }
    }
}

typedef float f32x16 __attribute__((ext_vector_type(16)));
typedef short s16x4 __attribute__((ext_vector_type(4)));
typedef unsigned u32x4 __attribute__((ext_vector_type(4)));
__device__ __forceinline__ unsigned offb(unsigned row, unsigned ch) { return 256u * row + 16u * (ch ^ (((row & 3) << 2) | ((row >> 2) & 3))); }
__device__ __forceinline__ s16x4 tr_rd(LAS unsigned char* p) { return __builtin_bit_cast(s16x4, __builtin_amdgcn_ds_read_tr16_b64_v4i16((LAS s16x4*)p)); }
typedef float f32x2_t __attribute__((ext_vector_type(2))); typedef __bf16 bf16x2_t __attribute__((ext_vector_type(2)));
__device__ __forceinline__ unsigned cvtpk(float lo, float hi) { const f32x2_t v = {lo, hi}; const bf16x2_t b = __builtin_convertvector(v, bf16x2_t); return __builtin_bit_cast(unsigned, b); }
constexpr int ATT_BUF = 32768;

__device__ __forceinline__ void attn_unit(const Frame& F, const bf16* QKV, bf16* ZYh, const float* subln, float lam, float lam_init, int bl, int h, int qb) {
    const int tid = F.tid, lane = F.lane, w = F.wave, m = w >> 2, wq = w & 3, r32 = lane & 31, hi = lane >> 5;
    const int rowbase = bl * SEQ, q0 = qb * 128 + wq * 32, qpos = q0 + r32;
    const GAS bf16* Kg = (const GAS bf16*)(QKV + (size_t)rowbase * 3072 + 1024 + h * 128);
    const GAS bf16* Vg = (const GAS bf16*)(QKV + (size_t)rowbase * 3072 + 2048 + h * 128);
    bf16x8 qf[4];
    { const GAS bf16* qp = (const GAS bf16*)(QKV + (size_t)(rowbase + qpos) * 3072 + h * 128 + m * 64 + hi * 8);
#pragma unroll
      for (int s = 0; s < 4; ++s) qf[s] = *(const GAS bf16x8*)(qp + 16 * s); }
    const float slope2 = exp2f(-(float)(h + 1)) * LOG2E;
    const int NT = 2 * qb + 2;
    const int srow = tid >> 4, sch = tid & 15;
    const size_t goff0 = (size_t)srow * 3072 + sch * 8, goff1 = goff0 + (size_t)32 * 3072;
    const unsigned so0 = offb(srow, sch), so1 = offb(srow + 32, sch);
    unsigned ka[4];
#pragma unroll
    for (int s = 0; s < 4; ++s) ka[s] = offb(r32, 8 * m + 2 * s + hi);
    unsigned va[2][4];
    { const unsigned blk = (lane >> 4) & 1, q_ = (lane & 15) >> 2, p = lane & 3;
#pragma unroll
      for (int t = 0; t < 2; ++t)
#pragma unroll
          for (int dvb = 0; dvb < 4; ++dvb) va[t][dvb] = offb(8 * t + 4 * hi + q_, 4 * dvb + 2 * blk + (p >> 1)) + 8 * (p & 1) + 16384; }
    f32x16 O[4];
#pragma unroll
    for (int d = 0; d < 4; ++d)
#pragma unroll
        for (int r = 0; r < 16; ++r) O[d][r] = 0.f;
    float m_run = -INFINITY, l_run = 0.f;
    u32x4 stK0, stK1, stV0, stV1;
    stK0 = *(const GAS u32x4*)(Kg + goff0); stK1 = *(const GAS u32x4*)(Kg + goff1); stV0 = *(const GAS u32x4*)(Vg + goff0); stV1 = *(const GAS u32x4*)(Vg + goff1);
    *(LAS u32x4*)(F.lds + so0) = stK0; *(LAS u32x4*)(F.lds + so1) = stK1; *(LAS u32x4*)(F.lds + 16384 + so0) = stV0; *(LAS u32x4*)(F.lds + 16384 + so1) = stV1;
    __syncthreads();
#pragma unroll 1
    for (int t = 0; t < NT; ++t) {
        const int k0 = 64 * t;
        const unsigned bufo = (unsigned)(t & 1) * ATT_BUF;
        if (t + 1 < NT) { const size_t tg = (size_t)(k0 + 64) * 3072;
            stK0 = *(const GAS u32x4*)(Kg + tg + goff0); stK1 = *(const GAS u32x4*)(Kg + tg + goff1); stV0 = *(const GAS u32x4*)(Vg + tg + goff0); stV1 = *(const GAS u32x4*)(Vg + tg + goff1); }
        if (k0 <= q0 + 31) {
            f32x16 p0, p1;
            { const float lb = slope2 * (float)(k0 + 4 * hi - qpos);
#pragma unroll
              for (int r = 0; r < 16; ++r) { const float c = (float)((r & 3) + 8 * (r >> 2)); p0[r] = lb + slope2 * c; p1[r] = lb + slope2 * (c + 32.f); } }
#pragma unroll
            for (int s = 0; s < 4; ++s) {
                const bf16x8 kf0 = *(const LAS bf16x8*)(F.lds + bufo + ka[s]);
                const bf16x8 kf1 = *(const LAS bf16x8*)(F.lds + bufo + ka[s] + 8192);
                p0 = __builtin_amdgcn_mfma_f32_32x32x16_bf16(kf0, qf[s], p0, 0, 0, 0);
                p1 = __builtin_amdgcn_mfma_f32_32x32x16_bf16(kf1, qf[s], p1, 0, 0, 0);
            }
            if (k0 + 63 > q0) {
#pragma unroll
                for (int r = 0; r < 16; ++r) { const int kp = k0 + (r & 3) + 8 * (r >> 2) + 4 * hi; if (kp > qpos) p0[r] = -INFINITY; if (kp + 32 > qpos) p1[r] = -INFINITY; }
            }
            float rm = fmaxf(p0[0], p1[0]);
#pragma unroll
            for (int r = 1; r < 16; ++r) rm = fmaxf(rm, fmaxf(p0[r], p1[r]));
            rm = fmaxf(rm, bperm_xor(rm, lane, 32));
            if (__any(rm > m_run)) {
                const float mn = fmaxf(m_run, rm), alpha = __builtin_amdgcn_exp2f(m_run - mn);
                m_run = mn; l_run *= alpha;
#pragma unroll
                for (int d = 0; d < 4; ++d)
#pragma unroll
                    for (int r = 0; r < 16; ++r) O[d][r] *= alpha;
            }
            float ps = 0.f;
#pragma unroll
            for (int r = 0; r < 16; ++r) { p0[r] = __builtin_amdgcn_exp2f(p0[r] - m_run); p1[r] = __builtin_amdgcn_exp2f(p1[r] - m_run); ps += p0[r] + p1[r]; }
            l_run += ps;
            bf16x8 pf[4];
            { u32x4 a;
              a.x = cvtpk(p0[0], p0[1]); a.y = cvtpk(p0[2], p0[3]); a.z = cvtpk(p0[4], p0[5]); a.w = cvtpk(p0[6], p0[7]); pf[0] = __builtin_bit_cast(bf16x8, a);
              a.x = cvtpk(p0[8], p0[9]); a.y = cvtpk(p0[10], p0[11]); a.z = cvtpk(p0[12], p0[13]); a.w = cvtpk(p0[14], p0[15]); pf[1] = __builtin_bit_cast(bf16x8, a);
              a.x = cvtpk(p1[0], p1[1]); a.y = cvtpk(p1[2], p1[3]); a.z = cvtpk(p1[4], p1[5]); a.w = cvtpk(p1[6], p1[7]); pf[2] = __builtin_bit_cast(bf16x8, a);
              a.x = cvtpk(p1[8], p1[9]); a.y = cvtpk(p1[10], p1[11]); a.z = cvtpk(p1[12], p1[13]); a.w = cvtpk(p1[14], p1[15]); pf[3] = __builtin_bit_cast(bf16x8, a); }
#pragma unroll
            for (int dvb = 0; dvb < 4; ++dvb)
#pragma unroll
                for (int s = 0; s < 4; ++s) {
                    const s16x4 lo = tr_rd(F.lds + bufo + va[0][dvb] + 4096 * s), hv = tr_rd(F.lds + bufo + va[1][dvb] + 4096 * s);
                    const bf16x8 vf = (bf16x8){lo[0], lo[1], lo[2], lo[3], hv[0], hv[1], hv[2], hv[3]};
                    O[dvb] = __builtin_amdgcn_mfma_f32_32x32x16_bf16(vf, pf[s], O[dvb], 0, 0, 0);
                }
        }
        if (t + 1 < NT) { const unsigned nb = (unsigned)((t + 1) & 1) * ATT_BUF;
            *(LAS u32x4*)(F.lds + nb + so0) = stK0; *(LAS u32x4*)(F.lds + nb + so1) = stK1; *(LAS u32x4*)(F.lds + nb + 16384 + so0) = stV0; *(LAS u32x4*)(F.lds + nb + 16384 + so1) = stV1; }
        __syncthreads();
    }
    { const float lt = l_run + bperm_xor(l_run, lane, 32), inv = 1.f / lt;
#pragma unroll
      for (int d = 0; d < 4; ++d)
#pragma unroll
          for (int r = 0; r < 16; ++r) O[d][r] *= inv; }
    LAS float* ex = (LAS float*)F.lds + (size_t)wq * 4096 + lane;
    if (m == 1) {
#pragma unroll
        for (int d = 0; d < 4; ++d)
#pragma unroll
            for (int r = 0; r < 16; ++r) ex[(d * 16 + r) * 64] = O[d][r];
    }
    __syncthreads();
    if (m == 0) {
        float ss = 0.f;
#pragma unroll
        for (int d = 0; d < 4; ++d)
#pragma unroll
            for (int r = 0; r < 16; ++r) { const float o = O[d][r] - lam * ex[(d * 16 + r) * 64]; O[d][r] = o; ss += o * o; }
        ss += bperm_xor(ss, lane, 32);
        const float rs = rsqrtf(ss * (1.f / 128.f) + EPS) * (1.f - lam_init);
        GAS bf16* zrow = (GAS bf16*)(ZYh + (size_t)(rowbase + qpos) * 2048 + h * 128);
#pragma unroll
        for (int d = 0; d < 4; ++d)
#pragma unroll
            for (int g = 0; g < 4; ++g) {
                const int dv0 = 32 * d + 8 * g + 4 * hi;
                const f32x4 sg = *(const GAS f32x4*)(subln + dv0);
                GAS unsigned long long* zp = (GAS unsigned long long*)(zrow + dv0);
                const unsigned long long zw = *zp; const unsigned z01 = (unsigned)zw, z23 = (unsigned)(zw >> 32);
                const float y0 = O[d][4 * g + 0] * rs * sg.x * silu_f(bflo(z01)), y1 = O[d][4 * g + 1] * rs * sg.y * silu_f(bfhi(z01));
                const float y2 = O[d][4 * g + 2] * rs * sg.z * silu_f(bflo(z23)), y3 = O[d][4 * g + 3] * rs * sg.w * silu_f(bfhi(z23));
                *zp = (unsigned long long)cvtpk(y0, y1) | ((unsigned long long)cvtpk(y2, y3) << 32);
            }
    }
    __syncthreads();
}
__device__ __forceinline__ void attn_phase(const Frame& F, unsigned* qctr, volatile LAS unsigned* slot, const bf16* QKV, bf16* ZYh, const float* subln, float lam, float lam_init) {
    for (;;) {
        if (F.tid == 0) slot[0] = __hip_atomic_fetch_add(qctr, 1u, __ATOMIC_RELAXED, __HIP_MEMORY_SCOPE_AGENT);
        __syncthreads();
        const unsigned item = slot[0];
        __syncthreads();
        if (item >= 512u) break;
        const int qb = 15 - (int)(item >> 5), bh = (int)(item & 31);
        attn_unit(F, QKV, ZYh, subln, lam, lam_init, bh >> 3, bh & 7, qb);
    }
}
struct Args { const float* in[21]; float* out; unsigned char* ws; };
#define GRID_BAR() do { XcdBarrier b_ = bar; asm volatile("" : "+s"(b_.bar), "+s"(b_.x)); xcd_barrier(b_); } while (0)
template <int l, int hb> __device__ __forceinline__ void half_fn(Frame& F, const XcdBarrier& bar, volatile LAS unsigned* MISC) {
    const CAS unsigned char* kp;
            PHASE_BEGIN();
            { unsigned char* ws = WSP; bf16* ZYh = (bf16*)(ws + WS_ZY) + (size_t)hb * HBROWS * 2048;
              pg8::Gemm g{(bf16*)(ws + WS_H) + (size_t)hb * HBROWS * DM, (bf16*)(ws + WS_WIN), HBROWS, NPROJ, DM}; pg8::StaticOrder S; S.init(HBROWS, NPROJ, F.G, F.bx);
              pg8::EpiProj E{(bf16*)(ws + WS_QKV), ZYh, (bf16*)(ws + WS_DNQ), (bf16*)(ws + WS_GLQ), (float*)(ws + WS_SM), 0.125f * LOG2E};
              pg8::gemm_phase<pg8::EpiProj, pg8::StaticOrder, true, true>(F.lds, g, S, E); }
            GRID_BAR();
            PHASE_BEGIN();
            { unsigned char* ws = WSP; const bf16* DNQ = (const bf16*)(ws + WS_DNQ); bf16* DNC = (bf16*)(ws + WS_DNC); const float* SM = (const float*)(ws + WS_SM); float* GK = (float*)(ws + WS_GK);
              const float* convw = INP(IN_DNCONV) + (size_t)l * 4 * 1536; const float* w2 = INP(IN_GW2) + (size_t)l * 16 * 256; const float* gb = INP(IN_GB) + l * 256;
              for (int it = F.gw; it < HBROWS * 12; it += F.NGW) dn_conv_item(DNQ, convw, DNC, it, F.lane);
              for (int it = F.gw; it < HBROWS * 4; it += F.NGW) gla_gk_item(SM, w2, gb, GK, it, F.lane);
              if (hb == 0) { const float* pl = INP(IN_P) + (size_t)l * NTOK * 256; bf16* PBF = (bf16*)(ws + WS_PBF);
                  for (int it = F.gw * 64 + F.lane; it < NTOK * 256 / 4; it += F.NGW * 64) { const f32x4 v = ((const GAS f32x4*)pl)[it]; ((GAS unsigned long long*)PBF)[it] = (unsigned long long)pk2(v.x, v.y) | ((unsigned long long)pk2(v.z, v.w) << 32); } } }
            GRID_BAR();
            PHASE_BEGIN();
            { unsigned char* ws = WSP; bf16* ZYh = (bf16*)(ws + WS_ZY) + (size_t)hb * HBROWS * 2048; const float* SM = (const float*)(ws + WS_SM);
              const int w = F.bx;
              if (w < 8) dn_scan_naive(F, (const bf16*)(ws + WS_DNC), SM, INP(IN_ALOG) + l * 4, INP(IN_DTB) + l * 4, INP(IN_DNNORM) + l * 128, ZYh, 2 * w);
              else if (w < 16) gla_scan_naive(F, (const bf16*)(ws + WS_GLQ), (const float*)(ws + WS_GK), INP(IN_GNORM) + l * 128, ZYh, 2 * (w - 8));
              { const float la = wave_sum(INP(IN_LQ1)[l * 64 + F.lane] * INP(IN_LK1)[l * 64 + F.lane], F.lane), lb = wave_sum(INP(IN_LQ2)[l * 64 + F.lane] * INP(IN_LK2)[l * 64 + F.lane], F.lane);
                const float lam_init = l == 0 ? 0.2f : 0.35550906f;
                const float lam = __expf(la) - __expf(lb) + lam_init;
                attn_phase(F, (unsigned*)(ws + WS_CTL) + CW_Q + 16 * (l * 2 + hb), MISC, (const bf16*)(ws + WS_QKV), ZYh, INP(IN_SUBLN) + l * 128, lam, lam_init); } }
            GRID_BAR();
}
template <int l> __device__ __forceinline__ void layer_fn(Frame& F, const XcdBarrier& bar, volatile LAS unsigned* MISC) {
    const CAS unsigned char* kp;
        PHASE_BEGIN();
        { unsigned char* ws = WSP;
          convert_weights(F, INP(IN_WIN), INP(IN_WOUT), INP(IN_PGATE), INP(IN_PPROJ), ws, l);
          if (l == 0) { bf16* H = (bf16*)(ws + WS_H); const float* x = INP(IN_X); const float* pre_g = INP(IN_PREG);
              for (int m = F.gw; m < NTOK; m += F.NGW) rms_row_to_bf16(x + (size_t)m * DM, pre_g, H + (size_t)m * DM, F.lane); } }
        GRID_BAR();
        half_fn<l, 0>(F, bar, MISC);
        half_fn<l, 1>(F, bar, MISC);
        PHASE_BEGIN();
        { unsigned char* ws = WSP;
          pg8::Gemm g{(bf16*)(ws + WS_ZY), (bf16*)(ws + WS_WOUT), NTOK, DM, 2048}; pg8::StaticOrder S; S.init(NTOK, DM, F.G, F.bx);
          pg8::EpiF32 E{(float*)(ws + WS_T1), DM};
          pg8::gemm_phase<pg8::EpiF32, pg8::StaticOrder, true, true>(F.lds, g, S, E); }
        PHASE_BEGIN();
        { unsigned char* ws = WSP;
          pg8::Gemm g{(bf16*)(ws + WS_PBF), (bf16*)(ws + WS_WP), NTOK, DM, 256}; pg8::StaticOrder S; S.init(NTOK, DM, F.G, F.bx);
          pg8::EpiBf E{(bf16*)(ws + WS_PP), DM};
          pg8::gemm_phase<pg8::EpiBf, pg8::StaticOrder, true, true>(F.lds, g, S, E); }
        GRID_BAR();
        PHASE_BEGIN();
        { unsigned char* ws = WSP; float* out = OUTP; const float* xin = l == 0 ? INP(IN_X) : (const float*)out; const float* T1 = (const float*)(ws + WS_T1); bf16* XB = (bf16*)(ws + WS_XB); const float* pg = INP(IN_POSTG) + l * DM;
          for (int m = F.gw; m < NTOK; m += F.NGW) norm_res_row(xin + (size_t)m * DM, T1 + (size_t)m * DM, pg, out + (size_t)m * DM, XB + (size_t)m * DM, nullptr, nullptr, F.lane); }
        GRID_BAR();
        PHASE_BEGIN();
        { unsigned char* ws = WSP;
          pg8::Gemm g{(bf16*)(ws + WS_XB), (bf16*)(ws + WS_WG), NTOK, DM, DM}; pg8::StaticOrder S; S.init(NTOK, DM, F.G, F.bx);
          pg8::EpiGate E{(const bf16*)(ws + WS_PP), (float*)(ws + WS_T1), DM};
          pg8::gemm_phase<pg8::EpiGate, pg8::StaticOrder, true, true>(F.lds, g, S, E); }
        GRID_BAR();
        PHASE_BEGIN();
        { unsigned char* ws = WSP; float* out = OUTP; const float* T1 = (const float*)(ws + WS_T1); const float* pn = INP(IN_PNORM) + l * DM;
          if (l == 0) {
            bf16* H = (bf16*)(ws + WS_H); const float* pre1 = INP(IN_PREG) + DM;
            for (int m = F.gw; m < NTOK; m += F.NGW) norm_res_row(out + (size_t)m * DM, T1 + (size_t)m * DM, pn, out + (size_t)m * DM, nullptr, pre1, H + (size_t)m * DM, F.lane);
          } else {
            for (int m = F.gw; m < NTOK; m += F.NGW) norm_res_row(out + (size_t)m * DM, T1 + (size_t)m * DM, pn, out + (size_t)m * DM, nullptr, nullptr, nullptr, F.lane);
          } }
}
__global__ void __launch_bounds__(NTHR, 2) mk_fwd(Args args) {
    extern __shared__ __attribute__((aligned(16))) unsigned char lds[];
    Frame F;
    F.lds = (LAS unsigned char*)lds;
    F.tid = threadIdx.x; F.lane = F.tid & 63; F.wave = __builtin_amdgcn_readfirstlane(F.tid >> 6);
    F.G = gridDim.x; { const int bx = blockIdx.x; F.vcu = (F.G % 8 == 0) ? (bx % 8) * (F.G / 8) + bx / 8 : bx; F.bx = bx; }
    F.gw = F.vcu * NWAVES + F.wave; F.NGW = F.G * NWAVES;
    volatile LAS unsigned* MISC = (volatile LAS unsigned*)(F.lds + MISC_OFF);
    for (int u = F.tid; u < (LDS_BYTES - LDSCTL_OFF) / 4; u += NTHR) ((LAS unsigned*)(F.lds + LDSCTL_OFF))[u] = 0u;
    __syncthreads();
    const XcdBarrier bar = xcd_barrier_post((unsigned*)(args.ws + WS_CTL) + CW_BAR, MISC + 8);
    layer_fn<0>(F, bar, MISC);
    layer_fn<1>(F, bar, MISC);
}

extern "C" void kernel_launch(void* const* d_in, const int* in_sizes, int n_in, void* d_out, int out_size, void* d_ws, size_t ws_size, hipStream_t stream) {
    static int grid = 0;
    if (grid == 0) {
        if (n_in != 21 || out_size != NTOK * DM || ws_size < WS_END) { fprintf(stderr, "kernel_launch: unexpected shapes (n_in %d out %d ws %zu)\n", n_in, out_size, ws_size); grid = -1; return; }
        int dev = 0, cus = 0;
        if (hipGetDevice(&dev) != hipSuccess || hipDeviceGetAttribute(&cus, hipDeviceAttributeMultiprocessorCount, dev) != hipSuccess) { grid = -1; return; }
        if (hipFuncSetAttribute((const void*)mk_fwd, hipFuncAttributeMaxDynamicSharedMemorySize, LDS_BYTES) != hipSuccess) { fprintf(stderr, "kernel_launch: hipFuncSetAttribute failed\n"); grid = -1; return; }
        int per_cu = 0;
        if (hipOccupancyMaxActiveBlocksPerMultiprocessor(&per_cu, (const void*)mk_fwd, NTHR, LDS_BYTES) != hipSuccess || per_cu < 1) fprintf(stderr, "kernel_launch: occupancy query says %d per CU\n", per_cu);
        (void)hipGetLastError();
        grid = cus;
    }
    if (grid < 0) return;
    if (hipMemsetAsync((char*)d_ws + WS_CTL, 0, CTL_ZERO_BYTES, stream) != hipSuccess) return;
    Args a{};
    for (int i = 0; i < 21; ++i) a.in[i] = (const float*)d_in[i];
    a.out = (float*)d_out; a.ws = (unsigned char*)d_ws;
    hipLaunchKernelGGL(mk_fwd, dim3(grid), dim3(NTHR), LDS_BYTES, stream, a);
}
```

```cpp
#include <hip/hip_runtime.h>
#include <cstdio>
#include <cstdint>
#include <cmath>
namespace pg8 {
#define PG8_LAS __attribute__((address_space(3)))
typedef unsigned short bf16_t;
typedef short bf16x8 __attribute__((ext_vector_type(8)));
typedef float f32x4 __attribute__((ext_vector_type(4)));
typedef unsigned u32x4 __attribute__((ext_vector_type(4)));
constexpr int BM = 256, BK = 64, HALF = 128, HTB = HALF * BK * 2  , STAGE_BYTES = 8 * HTB, NXCD = 8, WGM = 8;

__host__ __device__ __forceinline__ int lds_byte(int r, int c) { const int st = (r >> 4) * 2 + (c >> 5), rr = r & 15, cc = c & 31, ob = rr * 64 + cc * 2; return st * 1024 + (ob ^ (((ob >> 9) & 1) << 5)); }
__host__ __device__ __forceinline__ void stage_rc(int b, int& R, int& C) { const int st = b / 1024, sb = b % 1024, swz = sb ^ (((sb >> 9) & 1) << 5); R = (st >> 1) * 16 + swz / 64; C = (st & 1) * 32 + (swz % 64) / 2; }
__host__ __device__ __forceinline__ int perm32(int rho) { const int n = rho >> 4, i = rho & 15; return 8 * (i >> 2) + 4 * n + (i & 3); }

struct Unit { int pm, pn; };
struct Gemm { const bf16_t* A; const bf16_t* Bt; int M, N, K; };

struct StaticOrder {
    int nM, nN, nwg, G, c;
    __host__ __device__ void init(int M, int N, int G_, int c_) { nM = M / BM; nN = N / BM; nwg = nM * nN; G = G_; c = c_; }
    __host__ __device__ bool next(int i, Unit& u) const {
        const long L = (long)i * G + c; if (L >= nwg) return false;
        int wgid = (int)L; { const int q = nwg / NXCD, r = nwg % NXCD, xcd = wgid % NXCD, off = wgid / NXCD; wgid = (xcd < r ? xcd * (q + 1) : r * (q + 1) + (xcd - r) * q) + off; }
        const int nig = WGM * nN, gid = wgid / nig, fm = gid * WGM, gsz = (nM - fm) < WGM ? (nM - fm) : WGM;
        u.pm = fm + ((wgid % nig) % gsz); u.pn = (wgid % nig) / gsz; return true;
    }
    __device__ __forceinline__ void a_ready(const Unit&) const {}
    __device__ __forceinline__ void done(const Unit&) const {}
};

__device__ __forceinline__ unsigned cvt_pk_bf16(float lo, float hi) { unsigned r; asm volatile("v_cvt_pk_bf16_f32 %0, %1, %2" : "=v"(r) : "v"(lo), "v"(hi)); return r; }
typedef float f32x2 __attribute__((ext_vector_type(2)));
__device__ __forceinline__ float bf_lo(unsigned w) { return __builtin_bit_cast(float, w << 16); }
__device__ __forceinline__ float bf_hi(unsigned w) { return __builtin_bit_cast(float, w & 0xffff0000u); }
#define EPI_IDS() int t_ = threadIdx.x; asm volatile("" : "+v"(t_)); const int wid_ = t_ >> 6, wr = wid_ >> 2, wc = wid_ & 3, fr = t_ & 15, fq = (t_ & 63) >> 4
struct EpiProj {
    static constexpr bool PERM = true, AFTER_DRAIN = false;
    bf16_t* QKV;
    bf16_t* ZY;
    bf16_t* DNQ;
    bf16_t* GLQ;
    float* SM;
    float qscale;
    __device__ __forceinline__ void operator()(const f32x4 (&acc)[2][2][4][2], const Unit& u, int, int, int, int) const {
        EPI_IDS();
        const int pn = u.pn;
        const int row0 = u.pm * BM + wr * 64 + fr;
        if (pn == 30) {
            if (wc == 0) {
#pragma unroll
                for (int ai = 0; ai < 2; ++ai)
#pragma unroll
                    for (int m = 0; m < 4; ++m) { float* d = SM + (size_t)(row0 + ai * HALF + m * 16) * 32 + 8 * fq; *(f32x4*)d = acc[ai][0][m][0]; *(f32x4*)(d + 4) = acc[ai][0][m][1]; }
            }
            return;
        }
        bf16_t* base; int ldc, colt; float sc = 1.f;
        if (pn < 12) { base = QKV; ldc = 3072; colt = pn * 256; if (pn < 4) sc = qscale; }
        else if (pn < 16) { base = ZY; ldc = 2048; colt = (pn - 12) * 256; }
        else if (pn < 22) { base = DNQ; ldc = 1536; colt = (pn - 16) * 256; }
        else if (pn < 24) { base = ZY; ldc = 2048; colt = 1024 + (pn - 22) * 256; }
        else if (pn < 28) { base = GLQ; ldc = 1024; colt = (pn - 24) * 256; }
        else { base = ZY; ldc = 2048; colt = 1536 + (pn - 28) * 256; }
        const int col0 = colt + wc * 32 + 8 * fq;
#pragma unroll
        for (int ai = 0; ai < 2; ++ai)
#pragma unroll
            for (int m = 0; m < 4; ++m) { bf16_t* rowp = base + (size_t)(row0 + ai * HALF + m * 16) * ldc + col0;
#pragma unroll
                for (int bj = 0; bj < 2; ++bj) { const f32x4 v0 = acc[ai][bj][m][0] * sc, v1 = acc[ai][bj][m][1] * sc;
                    u32x4 w; w.x = cvt_pk_bf16(v0[0], v0[1]); w.y = cvt_pk_bf16(v0[2], v0[3]); w.z = cvt_pk_bf16(v1[0], v1[1]); w.w = cvt_pk_bf16(v1[2], v1[3]);
                    *(u32x4*)(rowp + bj * HALF) = w; } }
    }
};
struct EpiBf {
    static constexpr bool PERM = true, AFTER_DRAIN = false;
    bf16_t* O; int ldc;
    __device__ __forceinline__ void operator()(const f32x4 (&acc)[2][2][4][2], const Unit& u, int, int, int, int) const {
        EPI_IDS();
        const int row0 = u.pm * BM + wr * 64 + fr, col0 = u.pn * BM + wc * 32 + 8 * fq;
#pragma unroll
        for (int ai = 0; ai < 2; ++ai)
#pragma unroll
            for (int m = 0; m < 4; ++m) { bf16_t* rowp = O + (size_t)(row0 + ai * HALF + m * 16) * ldc + col0;
#pragma unroll
                for (int bj = 0; bj < 2; ++bj) { const f32x4 v0 = acc[ai][bj][m][0], v1 = acc[ai][bj][m][1];
                    u32x4 w; w.x = cvt_pk_bf16(v0[0], v0[1]); w.y = cvt_pk_bf16(v0[2], v0[3]); w.z = cvt_pk_bf16(v1[0], v1[1]); w.w = cvt_pk_bf16(v1[2], v1[3]);
                    *(u32x4*)(rowp + bj * HALF) = w; } }
    }
};
struct EpiF32 {
    static constexpr bool PERM = true, AFTER_DRAIN = false;
    float* O; int ldc;
    __device__ __forceinline__ void operator()(const f32x4 (&acc)[2][2][4][2], const Unit& u, int, int, int, int) const {
        EPI_IDS();
        const int row0 = u.pm * BM + wr * 64 + fr, col0 = u.pn * BM + wc * 32 + 8 * fq;
#pragma unroll
        for (int ai = 0; ai < 2; ++ai)
#pragma unroll
            for (int m = 0; m < 4; ++m) { float* rowp = O + (size_t)(row0 + ai * HALF + m * 16) * ldc + col0;
#pragma unroll
                for (int bj = 0; bj < 2; ++bj) { *(f32x4*)(rowp + bj * HALF) = acc[ai][bj][m][0]; *(f32x4*)(rowp + bj * HALF + 4) = acc[ai][bj][m][1]; } }
    }
};
struct EpiGate {
    static constexpr bool PERM = true, AFTER_DRAIN = false;
    const bf16_t* PP; float* O; int ldc;
    __device__ __forceinline__ void operator()(const f32x4 (&acc)[2][2][4][2], const Unit& u, int, int, int, int) const {
        EPI_IDS();
        const int row0 = u.pm * BM + wr * 64 + fr, col0 = u.pn * BM + wc * 32 + 8 * fq;
#pragma unroll
        for (int ai = 0; ai < 2; ++ai)
#pragma unroll
            for (int m = 0; m < 4; ++m) { const size_t off = (size_t)(row0 + ai * HALF + m * 16) * ldc + col0;
#pragma unroll
                for (int bj = 0; bj < 2; ++bj) { const u32x4 pw = *(const u32x4*)(PP + off + bj * HALF);
                    const f32x4 a0 = acc[ai][bj][m][0], a1 = acc[ai][bj][m][1];
                    f32x4 o0, o1;
                    o0[0] = bf_lo(pw.x) / (1.f + __expf(-a0[0])); o0[1] = bf_hi(pw.x) / (1.f + __expf(-a0[1]));
                    o0[2] = bf_lo(pw.y) / (1.f + __expf(-a0[2])); o0[3] = bf_hi(pw.y) / (1.f + __expf(-a0[3]));
                    o1[0] = bf_lo(pw.z) / (1.f + __expf(-a1[0])); o1[1] = bf_hi(pw.z) / (1.f + __expf(-a1[1]));
                    o1[2] = bf_lo(pw.w) / (1.f + __expf(-a1[2])); o1[3] = bf_hi(pw.w) / (1.f + __expf(-a1[3]));
                    *(f32x4*)(O + off + bj * HALF) = o0; *(f32x4*)(O + off + bj * HALF + 4) = o1; } }
    }
};
template <class Epi, class Sched, bool ALIGN_EPI = false, bool SP2 = false>
__device__ __forceinline__ void gemm_phase(PG8_LAS unsigned char* lds, const Gemm g, const Sched& S, const Epi& E) {
    int tid_ = threadIdx.x; asm volatile("" : "+v"(tid_));
    const int tid = tid_, wid = __builtin_amdgcn_readfirstlane(tid >> 6), lane = tid & 63, wr = wid >> 2, wc = wid & 3, fr = lane & 15, fq = lane >> 4;
    const int K = g.K, nt = K / BK;
    unsigned voffA[2], voffB[2];
#pragma unroll
    for (int i = 0; i < 2; ++i) { int R, C; stage_rc(tid * 16 + i * 8192, R, C); const int Rb = Epi::PERM ? ((R & ~31) + perm32(R & 31)) : R;
        voffA[i] = (unsigned)(R * K + C) * 2u; voffB[i] = (unsigned)(Rb * K + C) * 2u; }
    const size_t kstep = (size_t)(BK * 2);
    const size_t hstep = (size_t)HALF * K * 2;
    const size_t tstep = 2 * hstep;
    const unsigned ldsw = (unsigned)wid * 1024u;
    const int aoff = lds_byte(wr * 64 + fr, fq * 8), boff = lds_byte(wc * 32 + fr, fq * 8);
#define PG8_SA(b, h) (((b) * 2 + (h)) * HTB)
#define PG8_SB(b, h) ((4 + (b) * 2 + (h)) * HTB)
#define PG8_STAGE(bufoff, gbase, voff) do { _Pragma("unroll") for (int _i = 0; _i < 2; ++_i) \
        __builtin_amdgcn_global_load_lds((const unsigned*)((const char*)(gbase) + (voff)[_i]), (PG8_LAS unsigned*)(lds + (bufoff) + ldsw + _i * 8192), 16, 0, 0); } while (0)
#define PG8_LDA(dst, b, h) do { _Pragma("unroll") for (int m = 0; m < 4; ++m) _Pragma("unroll") for (int k = 0; k < 2; ++k) dst[m][k] = *(const PG8_LAS bf16x8*)(lds + PG8_SA(b, h) + aoff + m * 2048 + k * 1024); } while (0)
#define PG8_LDB(dst, b, h) do { _Pragma("unroll") for (int n = 0; n < 2; ++n) _Pragma("unroll") for (int k = 0; k < 2; ++k) dst[n][k] = *(const PG8_LAS bf16x8*)(lds + PG8_SB(b, h) + boff + n * 2048 + k * 1024); } while (0)
#define PG8_MMA(ai, bj, At, Bt) do { __builtin_amdgcn_s_setprio(1); _Pragma("unroll") for (int m = 0; m < 4; ++m) _Pragma("unroll") for (int n = 0; n < 2; ++n) _Pragma("unroll") for (int k = 0; k < 2; ++k) \
        acc[ai][bj][m][n] = __builtin_amdgcn_mfma_f32_16x16x32_bf16(Bt[n][k], At[m][k], acc[ai][bj][m][n], 0, 0, 0); __builtin_amdgcn_s_setprio(0); } while (0)
#define PG8_WAIT_V(n) asm volatile("s_waitcnt vmcnt(" #n ")" ::: "memory")
#define PG8_WAIT_L(n) asm volatile("s_waitcnt lgkmcnt(" #n ")" ::: "memory")
#define PG8_BAR __builtin_amdgcn_s_barrier()
#define PG8_SCHED __builtin_amdgcn_sched_barrier(0)
    Unit cur, nxt; int ui = 0;
    if (!S.next(0, cur)) return;
    f32x4 acc[2][2][4][2];
#pragma unroll
    for (int a = 0; a < 2; ++a)
#pragma unroll
        for (int b = 0; b < 2; ++b)
#pragma unroll
            for (int m = 0; m < 4; ++m)
#pragma unroll
                for (int n = 0; n < 2; ++n) acc[a][b][m][n] = (f32x4){0.f, 0.f, 0.f, 0.f};
    bf16x8 At[4][2], B0[2][2], B1[2][2];
    const char* cA = (const char*)g.A + (size_t)cur.pm * tstep; const char* cB = (const char*)g.Bt + (size_t)cur.pn * tstep;
    S.a_ready(cur);
    if constexpr (SP2) {
        PG8_STAGE(PG8_SB(0, 0), cB, voffB); PG8_STAGE(PG8_SB(0, 1), cB + hstep, voffB); PG8_STAGE(PG8_SA(0, 0), cA, voffA); PG8_STAGE(PG8_SA(0, 1), cA + hstep, voffA);
        if (wr == 1) PG8_BAR;
        PG8_WAIT_V(2); PG8_BAR;
        PG8_STAGE(PG8_SB(1, 0), cB + kstep, voffB); PG8_STAGE(PG8_SA(1, 0), cA + kstep, voffA); PG8_STAGE(PG8_SB(1, 1), cB + hstep + kstep, voffB);
        PG8_WAIT_V(6); PG8_BAR;
    } else {
        PG8_STAGE(PG8_SB(0, 0), cB, voffB); PG8_STAGE(PG8_SA(0, 0), cA, voffA); PG8_STAGE(PG8_SB(0, 1), cB + hstep, voffB); PG8_STAGE(PG8_SA(0, 1), cA + hstep, voffA);
        if (wr == 1) PG8_BAR;
        PG8_WAIT_V(4); PG8_BAR;
        PG8_STAGE(PG8_SB(1, 0), cB + kstep, voffB); PG8_STAGE(PG8_SA(1, 0), cA + kstep, voffA); PG8_STAGE(PG8_SB(1, 1), cB + hstep + kstep, voffB);
        PG8_WAIT_V(6); PG8_BAR;
    }
    for (;;) {
        const bool has_next = S.next(ui + 1, nxt);
        const char* nA = has_next ? (const char*)g.A + (size_t)nxt.pm * tstep : cA; const char* nB = has_next ? (const char*)g.Bt + (size_t)nxt.pn * tstep : cB;
        for (int t = 0; t < nt; t += 2) {
            const bool last = (t == nt - 2);
            const char* a1 = cA + (size_t)(t + 1) * kstep;
            const char* a2 = last ? nA : cA + (size_t)(t + 2) * kstep; const char* b2 = last ? nB : cB + (size_t)(t + 2) * kstep;
            const char* a3 = a2 + kstep; const char* b3 = b2 + kstep;
            if (last && has_next) S.a_ready(nxt);
            if constexpr (SP2) {
            PG8_LDB(B0, 0, 0); PG8_LDB(B1, 0, 1); PG8_SCHED; PG8_LDA(At, 0, 0); PG8_STAGE(PG8_SA(1, 1), a1 + hstep, voffA);
            PG8_WAIT_V(8); PG8_WAIT_L(0); PG8_BAR; PG8_MMA(0, 0, At, B0); PG8_MMA(0, 1, At, B1); PG8_BAR; PG8_SCHED;
            PG8_LDA(At, 0, 1); PG8_STAGE(PG8_SB(0, 0), b2, voffB); PG8_STAGE(PG8_SB(0, 1), b2 + hstep, voffB); PG8_STAGE(PG8_SA(0, 0), a2, voffA);
            PG8_WAIT_V(8); PG8_WAIT_L(0); PG8_BAR; PG8_MMA(1, 0, At, B0); PG8_MMA(1, 1, At, B1); PG8_BAR; PG8_SCHED;
            PG8_LDB(B0, 1, 0); PG8_LDB(B1, 1, 1); PG8_SCHED; PG8_LDA(At, 1, 0); PG8_STAGE(PG8_SA(0, 1), a2 + hstep, voffA);
            PG8_WAIT_V(8); PG8_WAIT_L(0); PG8_BAR; PG8_MMA(0, 0, At, B0); PG8_MMA(0, 1, At, B1); PG8_BAR; PG8_SCHED;
            PG8_LDA(At, 1, 1); PG8_STAGE(PG8_SB(1, 0), b3, voffB); PG8_STAGE(PG8_SB(1, 1), b3 + hstep, voffB); PG8_STAGE(PG8_SA(1, 0), a3, voffA);
            PG8_WAIT_V(8); PG8_WAIT_L(0); PG8_BAR; PG8_MMA(1, 0, At, B0); PG8_MMA(1, 1, At, B1); PG8_BAR; PG8_SCHED;
            } else {
            PG8_LDB(B0, 0, 0); PG8_SCHED; PG8_LDA(At, 0, 0); PG8_STAGE(PG8_SA(1, 1), a1 + hstep, voffA);
            PG8_WAIT_L(8); PG8_BAR; PG8_WAIT_L(0); PG8_MMA(0, 0, At, B0); PG8_BAR; PG8_SCHED;
            PG8_LDB(B1, 0, 1); PG8_STAGE(PG8_SB(0, 0), b2, voffB);
            PG8_BAR; PG8_WAIT_L(0); PG8_MMA(0, 1, At, B1); PG8_BAR;
            PG8_LDA(At, 0, 1); PG8_STAGE(PG8_SA(0, 0), a2, voffA);
            PG8_BAR; PG8_WAIT_L(0); PG8_MMA(1, 0, At, B0); PG8_BAR; PG8_SCHED;
            PG8_STAGE(PG8_SB(0, 1), b2 + hstep, voffB);
            PG8_WAIT_V(6); PG8_BAR; PG8_MMA(1, 1, At, B1); PG8_BAR;
            PG8_LDB(B0, 1, 0); PG8_SCHED; PG8_LDA(At, 1, 0); PG8_STAGE(PG8_SA(0, 1), a2 + hstep, voffA);
            PG8_WAIT_L(8); PG8_BAR; PG8_WAIT_L(0); PG8_MMA(0, 0, At, B0); PG8_BAR; PG8_SCHED;
            PG8_LDB(B1, 1, 1); PG8_STAGE(PG8_SB(1, 0), b3, voffB);
            PG8_BAR; PG8_WAIT_L(0); PG8_MMA(0, 1, At, B1); PG8_BAR;
            PG8_LDA(At, 1, 1); PG8_STAGE(PG8_SA(1, 0), a3, voffA);
            PG8_BAR; PG8_WAIT_L(0); PG8_MMA(1, 0, At, B0); PG8_BAR; PG8_SCHED;
            PG8_STAGE(PG8_SB(1, 1), b3 + hstep, voffB);
            PG8_WAIT_V(6); PG8_BAR; PG8_MMA(1, 1, At, B1); PG8_BAR;
            }
        }
        if constexpr (ALIGN_EPI) { if (wr == 0) PG8_BAR; }
        if constexpr (!Epi::AFTER_DRAIN) { E(acc, cur, wr, wc, fr, fq); S.done(cur); }
        if (!has_next) break;
#pragma unroll
        for (int a = 0; a < 2; ++a)
#pragma unroll
            for (int b = 0; b < 2; ++b)
#pragma unroll
                for (int m = 0; m < 4; ++m)
#pragma unroll
                    for (int n = 0; n < 2; ++n) acc[a][b][m][n] = (f32x4){0.f, 0.f, 0.f, 0.f};
        cur = nxt; cA = nA; cB = nB; ++ui;
        if constexpr (ALIGN_EPI) { if (wr == 1) PG8_BAR; }
    }
    PG8_WAIT_V(0);
    if constexpr (!ALIGN_EPI) { if (wr == 0) PG8_BAR; }
    PG8_BAR;
    if constexpr (Epi::AFTER_DRAIN) { E.fused(acc, cur, wr, wc, fr, fq, lds, wid, lane); S.done(cur); }
#undef PG8_SA
#undef PG8_SB
#undef PG8_STAGE
#undef PG8_LDA
#undef PG8_LDB
#undef PG8_MMA
#undef PG8_WAIT_V
#undef PG8_WAIT_L
#undef PG8_BAR
#undef PG8_SCHED
}
}
#define GAS __attribute__((address_space(1)))
#define LAS __attribute__((address_space(3)))
typedef unsigned short bf16;
typedef unsigned v4u __attribute__((ext_vector_type(4)));
typedef float f32x4 __attribute__((ext_vector_type(4)));
typedef short bf16x8 __attribute__((ext_vector_type(8)));
typedef GAS unsigned gu32;
typedef GAS unsigned long long gu64;
#define RLX_AGENT __ATOMIC_RELAXED, __HIP_MEMORY_SCOPE_AGENT
#define LDS_WAIT() asm volatile("s_waitcnt lgkmcnt(0)" ::: "memory")
#define VM_WAIT() asm volatile("s_waitcnt vmcnt(0)" ::: "memory")
__device__ __forceinline__ unsigned long long rt() { return __builtin_amdgcn_s_memrealtime(); }
__device__ __forceinline__ unsigned f2bf(float f) { unsigned u = __builtin_bit_cast(unsigned, f); return (u + 0x7fffu + ((u >> 16) & 1u)) >> 16; }
__device__ __forceinline__ unsigned pk2(float lo, float hi) { return f2bf(lo) | (f2bf(hi) << 16); }

#define XB_TMO      128
#define XB_XCNT(j)  (256  + 64 * (j))
#define XB_XSUB(j)  (1280 + 64 * (j))
#define XB_XGEN(j)  (2304 + 64 * (j))
#define XB_TOP      3328
#define XB_TOPGEN   3392
#define XCD_BAR_WORDS 3456
#define XB_SPIN_CAP (1u << 18)

__device__ __forceinline__ unsigned xb_ld(unsigned* p)              { return __hip_atomic_load(p, __ATOMIC_RELAXED, __HIP_MEMORY_SCOPE_AGENT); }
__device__ __forceinline__ unsigned xb_add(unsigned* p, unsigned v) { return __hip_atomic_fetch_add(p, v, __ATOMIC_RELAXED, __HIP_MEMORY_SCOPE_AGENT); }
__device__ __forceinline__ unsigned xb_xcc_id() { return (unsigned)__builtin_amdgcn_s_getreg((3 << 11) | 20) & 0xFu; }
#define XB_SPIN(cond, bar) do { unsigned _sp = 0; while (cond) { __builtin_amdgcn_s_sleep(1); \
    if ((++_sp & 255u) == 0u) { if (xb_ld(&(bar)[XB_TMO])) break; if (_sp > XB_SPIN_CAP) { atomicAdd(&(bar)[XB_TMO], 1u); break; } } } } while (0)

struct XcdBarrier {
    unsigned* bar; unsigned x;
    volatile LAS unsigned* st;
};

__device__ __forceinline__ XcdBarrier xcd_barrier_post(unsigned* bar, volatile LAS unsigned* st) {
    XcdBarrier b; b.bar = bar; b.x = xb_xcc_id(); b.st = st;
    if (threadIdx.x == 0) (void)xb_add(&bar[XB_XCNT(b.x)], 1u);
    return b;
}
__device__ __forceinline__ void xcd_barrier_complete(unsigned* bar, unsigned x, unsigned& nloc, unsigned& nx) {
    const unsigned G = gridDim.x * gridDim.y * gridDim.z;
    unsigned sum, cnt, mine, sp = 0u;
    for (;;) {
        sum = 0u; cnt = 0u; mine = 0u;
#pragma unroll
        for (unsigned j = 0; j < 16; ++j) { const unsigned c = xb_ld(&bar[XB_XCNT(j)]); sum += c; cnt += (c > 0u) ? 1u : 0u; mine = (j == x) ? c : mine; }
        if (sum == G) break;
        __builtin_amdgcn_s_sleep(1);
        if ((++sp & 255u) == 0u) { if (xb_ld(&bar[XB_TMO])) break; if (sp > XB_SPIN_CAP) { atomicAdd(&bar[XB_TMO], 1u); break; } }
    }
    nloc = mine > 0u ? mine : 1u; nx = cnt > 0u ? cnt : 1u;
}

__device__ __forceinline__ void xcd_barrier(const XcdBarrier& b) {
    asm volatile("s_waitcnt vmcnt(0)" ::: "memory");
    __syncthreads();
    if (threadIdx.x == 0) {
        unsigned* bar = b.bar;
        __builtin_amdgcn_s_waitcnt(0);
        unsigned nloc = b.st[0], nx = b.st[1];
        if (nloc == 0u) { xcd_barrier_complete(bar, b.x, nloc, nx); b.st[0] = nloc; b.st[1] = nx; }
        const unsigned old = xb_add(&bar[XB_XSUB(b.x)], 1u);
        const unsigned gen = old / nloc;
        if (old + 1u == (gen + 1u) * nloc) {
            __builtin_amdgcn_fence(__ATOMIC_RELEASE, "agent");
            asm volatile("s_waitcnt vmcnt(0)" ::: "memory");
            const unsigned og = xb_add(&bar[XB_TOP], 1u);
            const unsigned tg = og / nx;
            if (og + 1u == (tg + 1u) * nx) xb_add(&bar[XB_TOPGEN], 1u);
            else XB_SPIN(xb_ld(&bar[XB_TOPGEN]) == tg, bar);
            __builtin_amdgcn_fence(__ATOMIC_ACQUIRE, "agent");
            xb_add(&bar[XB_XGEN(b.x)], 1u);
            asm volatile("s_waitcnt vmcnt(0)" ::: "memory");
        } else {
            XB_SPIN(xb_ld(&bar[XB_XGEN(b.x)]) == gen, bar);
            __builtin_amdgcn_fence(__ATOMIC_ACQUIRE, "agent");
            asm volatile("s_waitcnt vmcnt(0)" ::: "memory");
        }
    }
    __syncthreads();
}

constexpr int NWAVES = 8, NTHR = 512;
constexpr int SEQ = 2048, DM = 1024, NTOK = 16384, HBROWS = 8192;
constexpr int D_IN = 7704, NPROJ = 7936;
constexpr float EPS = 1e-6f;
constexpr float LOG2E = 1.4426950408889634f;
constexpr int C_DB = 6144, C_GQ = 6152, C_GR = 7688;
constexpr size_t MiB = 1u << 20;
constexpr size_t WS_CTL = 0, CTL_ZERO_BYTES = 65536;
constexpr size_t WS_WIN = 1 * MiB, WS_WOUT = 17 * MiB, WS_WG = 21 * MiB, WS_WP = 23 * MiB;
constexpr size_t WS_H = 24 * MiB, WS_ZY = 56 * MiB;
constexpr size_t WS_QKV = 120 * MiB, WS_DNQ = 168 * MiB, WS_GLQ = 192 * MiB, WS_SM = 208 * MiB, WS_DNP = 209 * MiB  , WS_GP2 = 246 * MiB  ;
constexpr size_t WS_T1 = 120 * MiB, WS_PP = 184 * MiB, WS_XB = 216 * MiB, WS_PBF = 24 * MiB  , WS_END = 256 * MiB;
constexpr int CW_BAR = 1024, CW_Q = 256;
static_assert((CW_BAR + XCD_BAR_WORDS) * 4 <= (int)CTL_ZERO_BYTES, "ctl");
constexpr int RING_BYTES = 131072, LDSCTL_OFF = RING_BYTES, MISC_OFF = LDSCTL_OFF + 320, LDS_BYTES = 147456;

__device__ __forceinline__ float bperm_xor(float v, int lane, int o) { return __builtin_bit_cast(float, __builtin_amdgcn_ds_bpermute((lane ^ o) << 2, __builtin_bit_cast(int, v))); }
__device__ __forceinline__ float wave_sum(float v, int lane) {
#pragma unroll
    for (int o = 1; o < 64; o <<= 1) v += bperm_xor(v, lane, o);
    return v;
}
__device__ __forceinline__ float silu_f(float x) { return x / (1.f + __expf(-x)); }
__device__ __forceinline__ float sigmoid_f(float x) { return 1.f / (1.f + __expf(-x)); }
__device__ __forceinline__ float softplus_f(float x) { return fmaxf(x, 0.f) + log1pf(__expf(-fabsf(x))); }
__device__ __forceinline__ float bflo(unsigned w) { return __builtin_bit_cast(float, w << 16); }
__device__ __forceinline__ float bfhi(unsigned w) { return __builtin_bit_cast(float, w & 0xffff0000u); }
__device__ __forceinline__ float bf2f(bf16 h) { return __builtin_bit_cast(float, (unsigned)h << 16); }

struct Frame {
    LAS unsigned char* lds;
    int tid, lane, wave, vcu, G, gw, NGW, bx;
};
#define CAS __attribute__((address_space(4)))
#define PHASE_BEGIN() do { int t_ = threadIdx.x; asm volatile("" : "+v"(t_)); F.tid = t_; F.lane = t_ & 63; F.wave = __builtin_amdgcn_readfirstlane(t_ >> 6); \
    { int bx_ = blockIdx.x; asm volatile("" : "+s"(bx_)); F.vcu = (bx_ % 8) * (F.G / 8) + bx_ / 8; F.bx = bx_; } F.gw = F.vcu * NWAVES + F.wave; kp = (const CAS unsigned char*)__builtin_amdgcn_kernarg_segment_ptr(); asm volatile("" : "+s"(kp)); } while (0)
#define INP(k) (((const float* const CAS*)kp)[k])
#define OUTP   (((float* const CAS*)kp)[21])
#define WSP    (((unsigned char* const CAS*)kp)[22])
enum { IN_X = 0, IN_P, IN_WIN, IN_WOUT, IN_PREG, IN_POSTG, IN_LQ1, IN_LK1, IN_LQ2, IN_LK2, IN_SUBLN, IN_DNCONV, IN_ALOG, IN_DTB, IN_DNNORM, IN_GW2, IN_GB, IN_GNORM, IN_PPROJ, IN_PGATE, IN_PNORM };

__device__ __forceinline__ void transpose_item(const float* W, int ldw, int src0, bf16* WT, int K, int dst0, int nblk, LAS float* scr, int item, int lane) {
    const int kb = item / nblk, nb = item % nblk, k0 = 64 * kb, n0 = 32 * nb;
#pragma unroll 8
    for (int i = 0; i < 32; ++i) { const int kk = 2 * i + (lane >> 5); scr[kk * 33 + (lane & 31)] = W[(size_t)(k0 + kk) * ldw + src0 + n0 + (lane & 31)]; }
    LDS_WAIT(); asm volatile("" ::: "memory");
    const int c = lane & 7;
#pragma unroll
    for (int j = 0; j < 4; ++j) { const int n = (lane >> 3) + 8 * j; const LAS float* s = scr + (8 * c) * 33 + n;
        v4u o; o.x = pk2(s[0 * 33], s[1 * 33]); o.y = pk2(s[2 * 33], s[3 * 33]); o.z = pk2(s[4 * 33], s[5 * 33]); o.w = pk2(s[6 * 33], s[7 * 33]);
        *(GAS v4u*)(WT + (size_t)(dst0 + n0 + n) * K + k0 + 8 * c) = o; }
    LDS_WAIT(); asm volatile("" ::: "memory");
}
__device__ __forceinline__ void convert_weights(const Frame& F, const float* w_in0, const float* w_out0, const float* wg0, const float* wp0, unsigned char* ws, int l) {
    LAS float* scr = (LAS float*)(F.lds + F.wave * 16384);
    const float* w_in = w_in0 + (size_t)l * 1024 * D_IN; const float* w_out = w_out0 + (size_t)l * 2048 * 1024;
    const float* wg = wg0 + (size_t)l * 1024 * 1024; const float* wp = wp0 + (size_t)l * 256 * 1024;
    bf16* WIN = (bf16*)(ws + WS_WIN); bf16* WOUT = (bf16*)(ws + WS_WOUT); bf16* WG = (bf16*)(ws + WS_WG); bf16* WP = (bf16*)(ws + WS_WP);
    constexpr int I_A = 16 * 192, I_B = 16 * 48, I_O = 32 * 32, I_G = 16 * 32, I_P = 4 * 32, I_S = 256;
    constexpr int NIT = I_A + I_B + I_O + I_G + I_P + I_S;
    for (int it = F.gw; it < NIT; it += F.NGW) {
        int r = it;
        if (r < I_A) { transpose_item(w_in, D_IN, 0, WIN, 1024, 0, 192, scr, r, F.lane); continue; } r -= I_A;
        if (r < I_B) { transpose_item(w_in, D_IN, C_GQ, WIN, 1024, 6144, 48, scr, r, F.lane); continue; } r -= I_B;
        if (r < I_O) { transpose_item(w_out, 1024, 0, WOUT, 2048, 0, 32, scr, r, F.lane); continue; } r -= I_O;
        if (r < I_G) { transpose_item(wg, 1024, 0, WG, 1024, 0, 32, scr, r, F.lane); continue; } r -= I_G;
        if (r < I_P) { transpose_item(wp, 1024, 0, WP, 256, 0, 32, scr, r, F.lane); continue; } r -= I_P;
        const int src = r < 8 ? C_DB + r : (r < 24 ? C_GR + (r - 8) : -1);
#pragma unroll 4
        for (int j = 0; j < 16; ++j) { const int k = F.lane + 64 * j; const float v = src >= 0 ? w_in[(size_t)k * D_IN + src] : 0.f; WIN[(size_t)(7680 + r) * 1024 + k] = (bf16)f2bf(v); }
    }
}
__device__ __forceinline__ void rms_row_to_bf16(const float* xrow, const float* g, bf16* orow, int lane) {
    const GAS f32x4* xr = (const GAS f32x4*)xrow + lane; const GAS f32x4* gr = (const GAS f32x4*)g + lane;
    f32x4 v[4]; float s = 0.f;
#pragma unroll
    for (int j = 0; j < 4; ++j) { v[j] = xr[64 * j]; s += (v[j].x * v[j].x + v[j].y * v[j].y) + (v[j].z * v[j].z + v[j].w * v[j].w); }
    const float rs = rsqrtf(wave_sum(s, lane) * (1.f / 1024.f) + EPS);
    GAS unsigned long long* o8 = (GAS unsigned long long*)orow + lane;
#pragma unroll
    for (int j = 0; j < 4; ++j) { const f32x4 gg = gr[64 * j]; o8[64 * j] = (unsigned long long)pk2(v[j].x * rs * gg.x, v[j].y * rs * gg.y) | ((unsigned long long)pk2(v[j].z * rs * gg.z, v[j].w * rs * gg.w) << 32); }
}
__device__ __forceinline__ void norm_res_row(const float* xi, const float* t, const float* g, float* xo, bf16* xb, const float* g2, bf16* hn, int lane) {
    const GAS f32x4* tr = (const GAS f32x4*)t + lane; const GAS f32x4* gr = (const GAS f32x4*)g + lane; const GAS f32x4* xr = (const GAS f32x4*)xi + lane;
    f32x4 v[4]; float s = 0.f;
#pragma unroll
    for (int j = 0; j < 4; ++j) { v[j] = tr[64 * j]; s += (v[j].x * v[j].x + v[j].y * v[j].y) + (v[j].z * v[j].z + v[j].w * v[j].w); }
    const float rs = rsqrtf(wave_sum(s, lane) * (1.f / 1024.f) + EPS);
    float s2 = 0.f;
#pragma unroll
    for (int j = 0; j < 4; ++j) { const f32x4 gg = gr[64 * j]; const f32x4 xx = xr[64 * j]; v[j] = xx + v[j] * rs * gg; s2 += (v[j].x * v[j].x + v[j].y * v[j].y) + (v[j].z * v[j].z + v[j].w * v[j].w);
        ((GAS f32x4*)xo + lane)[64 * j] = v[j]; }
    if (xb) { GAS unsigned long long* o8 = (GAS unsigned long long*)xb + lane;
#pragma unroll
        for (int j = 0; j < 4; ++j) o8[64 * j] = (unsigned long long)pk2(v[j].x, v[j].y) | ((unsigned long long)pk2(v[j].z, v[j].w) << 32); }
    if (hn) { const float rs2 = rsqrtf(wave_sum(s2, lane) * (1.f / 1024.f) + EPS); const GAS f32x4* g2r = (const GAS f32x4*)g2 + lane; GAS unsigned long long* o8 = (GAS unsigned long long*)hn + lane;
#pragma unroll
        for (int j = 0; j < 4; ++j) { const f32x4 gg = g2r[64 * j]; o8[64 * j] = (unsigned long long)pk2(v[j].x * rs2 * gg.x, v[j].y * rs2 * gg.y) | ((unsigned long long)pk2(v[j].z * rs2 * gg.z, v[j].w * rs2 * gg.w) << 32); } }
}


typedef float f32x16 __attribute__((ext_vector_type(16)));
typedef short s16x4 __attribute__((ext_vector_type(4)));
typedef unsigned u32x4 __attribute__((ext_vector_type(4)));
__device__ __forceinline__ unsigned offb(unsigned row, unsigned ch) { return 256u * row + 16u * (ch ^ (((row & 3) << 2) | ((row >> 2) & 3))); }
__device__ __forceinline__ s16x4 tr_rd(LAS unsigned char* p) { return __builtin_bit_cast(s16x4, __builtin_amdgcn_ds_read_tr16_b64_v4i16((LAS s16x4*)p)); }
typedef float f32x2_t __attribute__((ext_vector_type(2))); typedef __bf16 bf16x2_t __attribute__((ext_vector_type(2)));
__device__ __forceinline__ unsigned cvtpk(float lo, float hi) { const f32x2_t v = {lo, hi}; const bf16x2_t b = __builtin_convertvector(v, bf16x2_t); return __builtin_bit_cast(unsigned, b); }
constexpr int ATT_BUF = 32768;

__device__ __forceinline__ void attn_unit(const Frame& F, const bf16* QKV, bf16* ZYh, const float* subln, float lam, float lam_init, int bl, int h, int qb) {
    const int tid = F.tid, lane = F.lane, w = F.wave, m = w >> 2, wq = w & 3, r32 = lane & 31, hi = lane >> 5;
    const int rowbase = bl * SEQ, q0 = qb * 128 + wq * 32, qpos = q0 + r32;
    const GAS bf16* Kg = (const GAS bf16*)(QKV + (size_t)rowbase * 3072 + 1024 + h * 128);
    const GAS bf16* Vg = (const GAS bf16*)(QKV + (size_t)rowbase * 3072 + 2048 + h * 128);
    bf16x8 qf[4];
    { const GAS bf16* qp = (const GAS bf16*)(QKV + (size_t)(rowbase + qpos) * 3072 + h * 128 + m * 64 + hi * 8);
#pragma unroll
      for (int s = 0; s < 4; ++s) qf[s] = *(const GAS bf16x8*)(qp + 16 * s); }
    const float slope2 = exp2f(-(float)(h + 1)) * LOG2E;
    const int NT = 2 * qb + 2;
    const int srow = tid >> 4, sch = tid & 15;
    const size_t goff0 = (size_t)srow * 3072 + sch * 8, goff1 = goff0 + (size_t)32 * 3072;
    const unsigned so0 = offb(srow, sch), so1 = offb(srow + 32, sch);
    unsigned ka[4];
#pragma unroll
    for (int s = 0; s < 4; ++s) ka[s] = offb(r32, 8 * m + 2 * s + hi);
    unsigned va[2][4];
    { const unsigned blk = (lane >> 4) & 1, q_ = (lane & 15) >> 2, p = lane & 3;
#pragma unroll
      for (int t = 0; t < 2; ++t)
#pragma unroll
          for (int dvb = 0; dvb < 4; ++dvb) va[t][dvb] = offb(8 * t + 4 * hi + q_, 4 * dvb + 2 * blk + (p >> 1)) + 8 * (p & 1) + 16384; }
    f32x16 O[4];
#pragma unroll
    for (int d = 0; d < 4; ++d)
#pragma unroll
        for (int r = 0; r < 16; ++r) O[d][r] = 0.f;
    float m_run = -INFINITY, l_run = 0.f;
    u32x4 stK0, stK1, stV0, stV1;
    stK0 = *(const GAS u32x4*)(Kg + goff0); stK1 = *(const GAS u32x4*)(Kg + goff1); stV0 = *(const GAS u32x4*)(Vg + goff0); stV1 = *(const GAS u32x4*)(Vg + goff1);
    *(LAS u32x4*)(F.lds + so0) = stK0; *(LAS u32x4*)(F.lds + so1) = stK1; *(LAS u32x4*)(F.lds + 16384 + so0) = stV0; *(LAS u32x4*)(F.lds + 16384 + so1) = stV1;
    __syncthreads();
#pragma unroll 1
    for (int t = 0; t < NT; ++t) {
        const int k0 = 64 * t;
        const unsigned bufo = (unsigned)(t & 1) * ATT_BUF;
        if (t + 1 < NT) { const size_t tg = (size_t)(k0 + 64) * 3072;
            stK0 = *(const GAS u32x4*)(Kg + tg + goff0); stK1 = *(const GAS u32x4*)(Kg + tg + goff1); stV0 = *(const GAS u32x4*)(Vg + tg + goff0); stV1 = *(const GAS u32x4*)(Vg + tg + goff1); }
        if (k0 <= q0 + 31) {
            f32x16 p0, p1;
            { const float lb = slope2 * (float)(k0 + 4 * hi - qpos);
#pragma unroll
              for (int r = 0; r < 16; ++r) { const float c = (float)((r & 3) + 8 * (r >> 2)); p0[r] = lb + slope2 * c; p1[r] = lb + slope2 * (c + 32.f); } }
#pragma unroll
            for (int s = 0; s < 4; ++s) {
                const bf16x8 kf0 = *(const LAS bf16x8*)(F.lds + bufo + ka[s]);
                const bf16x8 kf1 = *(const LAS bf16x8*)(F.lds + bufo + ka[s] + 8192);
                p0 = __builtin_amdgcn_mfma_f32_32x32x16_bf16(kf0, qf[s], p0, 0, 0, 0);
                p1 = __builtin_amdgcn_mfma_f32_32x32x16_bf16(kf1, qf[s], p1, 0, 0, 0);
            }
            if (k0 + 63 > q0) {
#pragma unroll
                for (int r = 0; r < 16; ++r) { const int kp = k0 + (r & 3) + 8 * (r >> 2) + 4 * hi; if (kp > qpos) p0[r] = -INFINITY; if (kp + 32 > qpos) p1[r] = -INFINITY; }
            }
            float rm = fmaxf(p0[0], p1[0]);
#pragma unroll
            for (int r = 1; r < 16; ++r) rm = fmaxf(rm, fmaxf(p0[r], p1[r]));
            rm = fmaxf(rm, bperm_xor(rm, lane, 32));
            if (__any(rm > m_run)) {
                const float mn = fmaxf(m_run, rm), alpha = __builtin_amdgcn_exp2f(m_run - mn);
                m_run = mn; l_run *= alpha;
#pragma unroll
                for (int d = 0; d < 4; ++d)
#pragma unroll
                    for (int r = 0; r < 16; ++r) O[d][r] *= alpha;
            }
            float ps = 0.f;
#pragma unroll
            for (int r = 0; r < 16; ++r) { p0[r] = __builtin_amdgcn_exp2f(p0[r] - m_run); p1[r] = __builtin_amdgcn_exp2f(p1[r] - m_run); ps += p0[r] + p1[r]; }
            l_run += ps;
            bf16x8 pf[4];
            { u32x4 a;
              a.x = cvtpk(p0[0], p0[1]); a.y = cvtpk(p0[2], p0[3]); a.z = cvtpk(p0[4], p0[5]); a.w = cvtpk(p0[6], p0[7]); pf[0] = __builtin_bit_cast(bf16x8, a);
              a.x = cvtpk(p0[8], p0[9]); a.y = cvtpk(p0[10], p0[11]); a.z = cvtpk(p0[12], p0[13]); a.w = cvtpk(p0[14], p0[15]); pf[1] = __builtin_bit_cast(bf16x8, a);
              a.x = cvtpk(p1[0], p1[1]); a.y = cvtpk(p1[2], p1[3]); a.z = cvtpk(p1[4], p1[5]); a.w = cvtpk(p1[6], p1[7]); pf[2] = __builtin_bit_cast(bf16x8, a);
              a.x = cvtpk(p1[8], p1[9]); a.y = cvtpk(p1[10], p1[11]); a.z = cvtpk(p1[12], p1[13]); a.w = cvtpk(p1[14], p1[15]); pf[3] = __builtin_bit_cast(bf16x8, a); }
#pragma unroll
            for (int dvb = 0; dvb < 4; ++dvb)
#pragma unroll
                for (int s = 0; s < 4; ++s) {
                    const s16x4 lo = tr_rd(F.lds + bufo + va[0][dvb] + 4096 * s), hv = tr_rd(F.lds + bufo + va[1][dvb] + 4096 * s);
                    const bf16x8 vf = (bf16x8){lo[0], lo[1], lo[2], lo[3], hv[0], hv[1], hv[2], hv[3]};
                    O[dvb] = __builtin_amdgcn_mfma_f32_32x32x16_bf16(vf, pf[s], O[dvb], 0, 0, 0);
                }
        }
        if (t + 1 < NT) { const unsigned nb = (unsigned)((t + 1) & 1) * ATT_BUF;
            *(LAS u32x4*)(F.lds + nb + so0) = stK0; *(LAS u32x4*)(F.lds + nb + so1) = stK1; *(LAS u32x4*)(F.lds + nb + 16384 + so0) = stV0; *(LAS u32x4*)(F.lds + nb + 16384 + so1) = stV1; }
        __syncthreads();
    }
    { const float lt = l_run + bperm_xor(l_run, lane, 32), inv = 1.f / lt;
#pragma unroll
      for (int d = 0; d < 4; ++d)
#pragma unroll
          for (int r = 0; r < 16; ++r) O[d][r] *= inv; }
    LAS float* ex = (LAS float*)F.lds + (size_t)wq * 4096 + lane;
    if (m == 1) {
#pragma unroll
        for (int d = 0; d < 4; ++d)
#pragma unroll
            for (int r = 0; r < 16; ++r) ex[(d * 16 + r) * 64] = O[d][r];
    }
    __syncthreads();
    if (m == 0) {
        float ss = 0.f;
#pragma unroll
        for (int d = 0; d < 4; ++d)
#pragma unroll
            for (int r = 0; r < 16; ++r) { const float o = O[d][r] - lam * ex[(d * 16 + r) * 64]; O[d][r] = o; ss += o * o; }
        ss += bperm_xor(ss, lane, 32);
        const float rs = rsqrtf(ss * (1.f / 128.f) + EPS) * (1.f - lam_init);
        GAS bf16* zrow = (GAS bf16*)(ZYh + (size_t)(rowbase + qpos) * 2048 + h * 128);
#pragma unroll
        for (int d = 0; d < 4; ++d)
#pragma unroll
            for (int g = 0; g < 4; ++g) {
                const int dv0 = 32 * d + 8 * g + 4 * hi;
                const f32x4 sg = *(const GAS f32x4*)(subln + dv0);
                GAS unsigned long long* zp = (GAS unsigned long long*)(zrow + dv0);
                const unsigned long long zw = *zp; const unsigned z01 = (unsigned)zw, z23 = (unsigned)(zw >> 32);
                const float y0 = O[d][4 * g + 0] * rs * sg.x * silu_f(bflo(z01)), y1 = O[d][4 * g + 1] * rs * sg.y * silu_f(bfhi(z01));
                const float y2 = O[d][4 * g + 2] * rs * sg.z * silu_f(bflo(z23)), y3 = O[d][4 * g + 3] * rs * sg.w * silu_f(bfhi(z23));
                *zp = (unsigned long long)cvtpk(y0, y1) | ((unsigned long long)cvtpk(y2, y3) << 32);
            }
    }
    __syncthreads();
}
__device__ __forceinline__ void attn_phase(const Frame& F, unsigned* qctr, volatile LAS unsigned* slot, const bf16* QKV, bf16* ZYh, const float* subln, float lam, float lam_init) {
    for (;;) {
        if (F.tid == 0) slot[0] = __hip_atomic_fetch_add(qctr, 1u, __ATOMIC_RELAXED, __HIP_MEMORY_SCOPE_AGENT);
        __syncthreads();
        const unsigned item = slot[0];
        __syncthreads();
        if (item >= 512u) break;
        const int qb = 15 - (int)(item >> 5), bh = (int)(item & 31);
        attn_unit(F, QKV, ZYh, subln, lam, lam_init, bh >> 3, bh & 7, qb);
    }
}

__device__ __forceinline__ int crow(int r, int h) { return (r & 3) + 8 * (r >> 2) + 4 * h; }
#define PACK8(x, s) __builtin_bit_cast(bf16x8, (u32x4){cvtpk((x)[8 * (s) + 0], (x)[8 * (s) + 1]), cvtpk((x)[8 * (s) + 2], (x)[8 * (s) + 3]), cvtpk((x)[8 * (s) + 4], (x)[8 * (s) + 5]), cvtpk((x)[8 * (s) + 6], (x)[8 * (s) + 7])})
#define MFMA32(a, b, c) __builtin_amdgcn_mfma_f32_32x32x16_bf16((a), (b), (c), 0, 0, 0)
__device__ __forceinline__ unsigned off_t64(unsigned row, unsigned ch) { return 128u * row + 16u * (ch ^ (row & 7)); }
constexpr int DNP_UNIT = 74752, DNP_WF = 0, DNP_QF = 16384, DNP_KF = 32768, DNP_AF = 49152, DNP_UF = 57344, DNP_GL = 73728, DNP_ABYTES = 57344;
constexpr int PL_K = 0, PL_Q = 16384, PL_KG = 32768, PL_VB = 49152, PL_M = 65536, PL_T = 81920, PL_GC = 90112, PL_BET = 90368, PL_GT = 90624;

__device__ __forceinline__ void dn_pre_unit(const Frame& F, const bf16* DNQ, const float* SM, const float* convw, const float* a_log, const float* dt_bias, unsigned char* dnp, int bl, int h, int n) {
    int tid_ = F.tid; asm volatile("" : "+v"(tid_));
    const int tid = tid_, lane = tid & 63, w = __builtin_amdgcn_readfirstlane(tid >> 6), r32 = lane & 31, hi = lane >> 5;
    LAS unsigned char* L = F.lds;
    LAS float* gcs = (LAS float*)(L + PL_GC); LAS float* bet = (LAS float*)(L + PL_BET); LAS float* gtmp = (LAS float*)(L + PL_GT);
    {
        const int i = tid >> 3, cg = tid & 7, c0 = 16 * cg, t = 64 * n + i;
        const int row = bl * SEQ + t;
        float y[3][16];
#pragma unroll
        for (int wh = 0; wh < 3; ++wh)
#pragma unroll
            for (int c = 0; c < 16; ++c) y[wh][c] = 0.f;
#pragma unroll
        for (int jt = 0; jt < 4; ++jt) {
            if (t - 3 + jt >= 0) {
#pragma unroll
                for (int wh = 0; wh < 3; ++wh) {
                    const int col = wh * 512 + h * 128 + c0;
                    const GAS u32x4* xp = (const GAS u32x4*)(DNQ + (size_t)(row - 3 + jt) * 1536 + col);
                    const u32x4 x0 = xp[0], x1 = xp[1];
                    const GAS f32x4* wp = (const GAS f32x4*)(convw + jt * 1536 + col);
                    const f32x4 w0 = wp[0], w1 = wp[1], w2 = wp[2], w3 = wp[3];
                    y[wh][0] += w0.x * bflo(x0.x); y[wh][1] += w0.y * bfhi(x0.x); y[wh][2] += w0.z * bflo(x0.y); y[wh][3] += w0.w * bfhi(x0.y);
                    y[wh][4] += w1.x * bflo(x0.z); y[wh][5] += w1.y * bfhi(x0.z); y[wh][6] += w1.z * bflo(x0.w); y[wh][7] += w1.w * bfhi(x0.w);
                    y[wh][8] += w2.x * bflo(x1.x); y[wh][9] += w2.y * bfhi(x1.x); y[wh][10] += w2.z * bflo(x1.y); y[wh][11] += w2.w * bfhi(x1.y);
                    y[wh][12] += w3.x * bflo(x1.z); y[wh][13] += w3.y * bfhi(x1.z); y[wh][14] += w3.z * bflo(x1.w); y[wh][15] += w3.w * bfhi(x1.w);
                }
            }
        }
        float sq = 0.f, sk = 0.f;
#pragma unroll
        for (int c = 0; c < 16; ++c) { y[0][c] = silu_f(y[0][c]); y[1][c] = silu_f(y[1][c]); y[2][c] = silu_f(y[2][c]); sq += y[0][c] * y[0][c]; sk += y[1][c] * y[1][c]; }
        sq += bperm_xor(sq, lane, 1); sq += bperm_xor(sq, lane, 2); sq += bperm_xor(sq, lane, 4);
        sk += bperm_xor(sk, lane, 1); sk += bperm_xor(sk, lane, 2); sk += bperm_xor(sk, lane, 4);
        const float rq = rsqrtf(sq + EPS) * 0.08838834764831845f, rk = rsqrtf(sk + EPS);
        const float beta = sigmoid_f(SM[(size_t)row * 32 + h]);
        const float g = -__expf(a_log[h]) * softplus_f(SM[(size_t)row * 32 + 4 + h] + dt_bias[h]);
        if (cg == 0) { gtmp[i] = g; bet[i] = beta; }
        __syncthreads();
        if (w == 0) {
            float v = gtmp[lane];
#pragma unroll
            for (int o = 1; o < 64; o <<= 1) { const float tt = __builtin_bit_cast(float, __builtin_amdgcn_ds_bpermute(((lane - o) & 63) << 2, __builtin_bit_cast(int, v))); if (lane >= o) v += tt; }
            gcs[lane] = v;
        }
        __syncthreads();
        const float eg = __expf(gcs[i]);
        u32x4 a0, a1;
#define PK16(dst0, dst1, EXPR) do { float e_[16]; _Pragma("unroll") for (int c = 0; c < 16; ++c) { e_[c] = (EXPR); } \
        dst0 = (u32x4){cvtpk(e_[0], e_[1]), cvtpk(e_[2], e_[3]), cvtpk(e_[4], e_[5]), cvtpk(e_[6], e_[7])}; dst1 = (u32x4){cvtpk(e_[8], e_[9]), cvtpk(e_[10], e_[11]), cvtpk(e_[12], e_[13]), cvtpk(e_[14], e_[15])}; } while (0)
        const unsigned o0 = offb(i, 2 * cg), o1 = offb(i, 2 * cg + 1);
        PK16(a0, a1, y[0][c] * rq);              *(LAS u32x4*)(L + PL_Q + o0) = a0;  *(LAS u32x4*)(L + PL_Q + o1) = a1;
        PK16(a0, a1, y[1][c] * rk);              *(LAS u32x4*)(L + PL_K + o0) = a0;  *(LAS u32x4*)(L + PL_K + o1) = a1;
        PK16(a0, a1, y[1][c] * (rk * beta * eg)); *(LAS u32x4*)(L + PL_KG + o0) = a0; *(LAS u32x4*)(L + PL_KG + o1) = a1;
        PK16(a0, a1, y[2][c] * beta);            *(LAS u32x4*)(L + PL_VB + o0) = a0; *(LAS u32x4*)(L + PL_VB + o1) = a1;
#undef PK16
        __syncthreads();
    }
    const float gl = gcs[63];
    if (w < 3) {
        const int ia = (w == 1) ? 0 : 1, jb = (w == 2) ? 1 : 0;
        f32x16 d;
#pragma unroll
        for (int r = 0; r < 16; ++r) d[r] = 0.f;
#pragma unroll
        for (int s = 0; s < 8; ++s) {
            const bf16x8 af = *(const LAS bf16x8*)(L + PL_K + offb(32 * ia + r32, 2 * s + hi));
            const bf16x8 bfr = *(const LAS bf16x8*)(L + PL_K + offb(32 * jb + r32, 2 * s + hi));
            d = MFMA32(af, bfr, d);
        }
        const int j = 32 * jb + r32; const float gj = gcs[j];
        LAS float* M = (LAS float*)(L + PL_M);
#pragma unroll
        for (int r = 0; r < 16; ++r) { const int i = 32 * ia + crow(r, hi); M[i * 64 + j] = (j < i) ? bet[i] * d[r] * __expf(gcs[i] - gj) : 0.f; }
    } else if (w < 6) {
        const int jb = (w == 5) ? 1 : 0, ib = (w == 3) ? 0 : 1;
        f32x16 d;
#pragma unroll
        for (int r = 0; r < 16; ++r) d[r] = 0.f;
#pragma unroll
        for (int s = 0; s < 8; ++s) {
            const bf16x8 af = *(const LAS bf16x8*)(L + PL_K + offb(32 * jb + r32, 2 * s + hi));
            const bf16x8 bfr = *(const LAS bf16x8*)(L + PL_Q + offb(32 * ib + r32, 2 * s + hi));
            d = MFMA32(af, bfr, d);
        }
        const int i = 32 * ib + r32; const float gi = gcs[i];
#pragma unroll
        for (int r = 0; r < 16; ++r) { const int j = 32 * jb + crow(r, hi); d[r] = (j <= i) ? d[r] * __expf(gi - gcs[j]) : 0.f; }
        const int idx = (w - 3) * 2;
        *(GAS bf16x8*)(dnp + DNP_AF + (idx + 0) * 1024 + lane * 16) = PACK8(d, 0);
        *(GAS bf16x8*)(dnp + DNP_AF + (idx + 1) * 1024 + lane * 16) = PACK8(d, 1);
    }
    __syncthreads();
    if (w == 0) {
        unsigned mb_ = (unsigned)(uintptr_t)(L + PL_M); asm volatile("" : "+v"(mb_));
        int lane_c = lane; asm volatile("" : "+v"(lane_c));
        const LAS float* M = (const LAS float*)(uintptr_t)mb_;
        float T[64];
#pragma unroll
        for (int i = 0; i < 64; ++i) {
            float a0 = (lane_c == i) ? 1.f : 0.f, a1 = 0.f, a2 = 0.f, a3 = 0.f;
#pragma unroll
            for (int j = 0; j < i; ++j) { const float mv = M[i * 64 + j];
                if ((j & 3) == 0) a0 -= mv * T[j]; else if ((j & 3) == 1) a1 -= mv * T[j]; else if ((j & 3) == 2) a2 -= mv * T[j]; else a3 -= mv * T[j]; }
            T[i] = (a0 + a1) + (a2 + a3);
        }
        LAS bf16* Ti = (LAS bf16*)(L + PL_T);
#pragma unroll
        for (int i = 0; i < 64; ++i) Ti[(off_t64(i, lane >> 3) >> 1) + (lane & 7)] = (bf16)f2bf(T[i]);
    } else {
        for (int f = w - 1; f < 32; f += 7) {
            if (f < 16) { const int ib = f >> 3, db = (f >> 1) & 3, s = f & 1; const int i = 32 * ib + r32;
                const unsigned long long lo = *(const LAS unsigned long long*)(L + PL_Q + offb(i, 4 * db + 2 * s) + 8 * hi), hv = *(const LAS unsigned long long*)(L + PL_Q + offb(i, 4 * db + 2 * s + 1) + 8 * hi);
                const float eg = __expf(gcs[i]);
                u32x4 o; o.x = cvtpk(bflo((unsigned)lo) * eg, bfhi((unsigned)lo) * eg); o.y = cvtpk(bflo((unsigned)(lo >> 32)) * eg, bfhi((unsigned)(lo >> 32)) * eg);
                o.z = cvtpk(bflo((unsigned)hv) * eg, bfhi((unsigned)hv) * eg); o.w = cvtpk(bflo((unsigned)(hv >> 32)) * eg, bfhi((unsigned)(hv >> 32)) * eg);
                *(GAS u32x4*)(dnp + DNP_QF + f * 1024 + lane * 16) = o;
            } else { const int g = f - 16, db = g >> 2, ib = (g >> 1) & 1, s = g & 1;
                const unsigned blk = (lane >> 4) & 1, q_ = (lane & 15) >> 2, p = lane & 3;
                const int rb = 32 * ib + 16 * s + 4 * hi;
                const s16x4 lo = tr_rd(L + PL_K + offb(rb + q_, 4 * db + 2 * blk + (p >> 1)) + 8 * (p & 1)), hv = tr_rd(L + PL_K + offb(rb + 8 + q_, 4 * db + 2 * blk + (p >> 1)) + 8 * (p & 1));
                float e[8];
#pragma unroll
                for (int x = 0; x < 4; ++x) { e[x] = bf2f((bf16)lo[x]) * __expf(gl - gcs[rb + x]); e[4 + x] = bf2f((bf16)hv[x]) * __expf(gl - gcs[rb + 8 + x]); }
                u32x4 o; o.x = cvtpk(e[0], e[1]); o.y = cvtpk(e[2], e[3]); o.z = cvtpk(e[4], e[5]); o.w = cvtpk(e[6], e[7]);
                *(GAS u32x4*)(dnp + DNP_KF + g * 1024 + lane * 16) = o;
            }
        }
        if (w == 1 && lane == 0) *(GAS float*)(dnp + DNP_GL) = __expf(gl);
    }
    __syncthreads();
    {
        const int ib = w >> 2, x = w & 3;
        const unsigned blk = (lane >> 4) & 1, q_ = (lane & 15) >> 2, p = lane & 3;
        f32x16 du, dw;
#pragma unroll
        for (int r = 0; r < 16; ++r) { du[r] = 0.f; dw[r] = 0.f; }
#pragma unroll
        for (int s = 0; s < 4; ++s) {
            const bf16x8 tf = *(const LAS bf16x8*)(L + PL_T + off_t64(32 * ib + r32, 2 * s + hi));
            const int rb = 16 * s + 8 * hi;
            const unsigned cofs = 2 * blk + (p >> 1), bo = 8 * (p & 1);
            const s16x4 v0 = tr_rd(L + PL_VB + offb(rb + q_, 4 * x + cofs) + bo), v1 = tr_rd(L + PL_VB + offb(rb + 4 + q_, 4 * x + cofs) + bo);
            const s16x4 k0 = tr_rd(L + PL_KG + offb(rb + q_, 4 * x + cofs) + bo), k1 = tr_rd(L + PL_KG + offb(rb + 4 + q_, 4 * x + cofs) + bo);
            const bf16x8 vf = (bf16x8){v0[0], v0[1], v0[2], v0[3], v1[0], v1[1], v1[2], v1[3]};
            const bf16x8 kf = (bf16x8){k0[0], k0[1], k0[2], k0[3], k1[0], k1[1], k1[2], k1[3]};
            du = MFMA32(tf, vf, du);
            dw = MFMA32(kf, tf, dw);
        }
        { u32x4 o0, o1; o0.x = cvtpk(du[0], du[1]); o0.y = cvtpk(du[2], du[3]); o0.z = cvtpk(du[4], du[5]); o0.w = cvtpk(du[6], du[7]);
          o1.x = cvtpk(du[8], du[9]); o1.y = cvtpk(du[10], du[11]); o1.z = cvtpk(du[12], du[13]); o1.w = cvtpk(du[14], du[15]);
          GAS u32x4* up = (GAS u32x4*)(dnp + DNP_UF + ((x * 2 + ib) * 64 + lane) * 32); up[0] = o0; up[1] = o1; }
        *(GAS bf16x8*)(dnp + DNP_WF + ((ib * 4 + x) * 2 + 0) * 1024 + lane * 16) = PACK8(dw, 0);
        *(GAS bf16x8*)(dnp + DNP_WF + ((ib * 4 + x) * 2 + 1) * 1024 + lane * 16) = PACK8(dw, 1);
    }
    __syncthreads();
}

constexpr int SL_A = 0, SL_O = 57344;
__device__ __forceinline__ void scan_norm_rows(LAS unsigned char* Ostage, const float* gain, bf16* zy_chunk  , int w, int lane) {
    const f32x2_t gg = *(const GAS f32x2_t*)(gain + 2 * lane);
#pragma unroll
    for (int rr = 0; rr < 8; ++rr) { const int i = 8 * w + rr;
        const f32x2_t o = *(const LAS f32x2_t*)(Ostage + (i * 128 + 2 * lane) * 4);
        const float rs = rsqrtf(wave_sum(o.x * o.x + o.y * o.y, lane) * (1.f / 128.f) + EPS);
        GAS unsigned* zp = (GAS unsigned*)(zy_chunk + (size_t)i * 2048 + 2 * lane);
        const unsigned zw = *zp;
        *zp = cvtpk(o.x * rs * gg.x * silu_f(bflo(zw)), o.y * rs * gg.y * silu_f(bfhi(zw))); }
}
__device__ __forceinline__ void dn_scan_wg(const Frame& F, const unsigned char* dnp_bh  , const float* gain, bf16* ZYh, int bl, int h) {
    const int tid = F.tid, lane = F.lane, w = F.wave, hi = lane >> 5;
    LAS unsigned char* L = F.lds;
    bf16* zy0 = ZYh + (size_t)(bl * SEQ) * 2048 + 1024 + h * 128;
    if (w < 4) {
        f32x16 St[4]; bf16x8 Sb[4][2];
#pragma unroll
        for (int d = 0; d < 4; ++d) {
#pragma unroll
            for (int r = 0; r < 16; ++r) St[d][r] = 0.f;
            Sb[d][0] = (bf16x8){0, 0, 0, 0, 0, 0, 0, 0}; Sb[d][1] = (bf16x8){0, 0, 0, 0, 0, 0, 0, 0}; }
        u32x4 un[4];
        { const GAS u32x4* up = (const GAS u32x4*)(dnp_bh + DNP_UF + (w * 2 * 64 + lane) * 32); un[0] = up[0]; un[1] = up[1]; un[2] = up[128]; un[3] = up[129]; }
        __syncthreads();
#pragma unroll 1
        for (int n = 0; n < 32; ++n) {
            const unsigned char* ub = dnp_bh + (size_t)n * DNP_UNIT;
            const float egl = *(const GAS float*)(ub + DNP_GL);
            const u32x4 uc0 = un[0], uc1 = un[1], uc2 = un[2], uc3 = un[3];
            if (n + 1 < 32) { const GAS u32x4* up = (const GAS u32x4*)(ub + DNP_UNIT + DNP_UF + (w * 2 * 64 + lane) * 32); un[0] = up[0]; un[1] = up[1]; un[2] = up[128]; un[3] = up[129]; }
            const LAS unsigned char* A = L + SL_A + lane * 16;
            f32x16 ws0, ws1, qs0, qs1;
#pragma unroll
            for (int r = 0; r < 16; ++r) { ws0[r] = 0.f; ws1[r] = 0.f; qs0[r] = 0.f; qs1[r] = 0.f; }
#pragma unroll
            for (int db = 0; db < 4; ++db)
#pragma unroll
                for (int s = 0; s < 2; ++s) {
                    ws0 = MFMA32(*(const LAS bf16x8*)(A + DNP_WF + ((0 * 4 + db) * 2 + s) * 1024), Sb[db][s], ws0);
                    ws1 = MFMA32(*(const LAS bf16x8*)(A + DNP_WF + ((1 * 4 + db) * 2 + s) * 1024), Sb[db][s], ws1);
                    qs0 = MFMA32(*(const LAS bf16x8*)(A + DNP_QF + ((0 * 4 + db) * 2 + s) * 1024), Sb[db][s], qs0);
                    qs1 = MFMA32(*(const LAS bf16x8*)(A + DNP_QF + ((1 * 4 + db) * 2 + s) * 1024), Sb[db][s], qs1);
                }
#pragma unroll
            for (int r = 0; r < 8; ++r) { const unsigned ua = (r < 4 ? uc0 : uc1)[r & 3], ub2 = (r < 4 ? uc2 : uc3)[r & 3];
                ws0[2 * r] = bflo(ua) - ws0[2 * r]; ws0[2 * r + 1] = bfhi(ua) - ws0[2 * r + 1]; ws1[2 * r] = bflo(ub2) - ws1[2 * r]; ws1[2 * r + 1] = bfhi(ub2) - ws1[2 * r + 1]; }
            const bf16x8 vn00 = PACK8(ws0, 0), vn01 = PACK8(ws0, 1), vn10 = PACK8(ws1, 0), vn11 = PACK8(ws1, 1);
            qs0 = MFMA32(*(const LAS bf16x8*)(A + DNP_AF + 0 * 1024), vn00, qs0);
            qs0 = MFMA32(*(const LAS bf16x8*)(A + DNP_AF + 1 * 1024), vn01, qs0);
            qs1 = MFMA32(*(const LAS bf16x8*)(A + DNP_AF + 2 * 1024), vn00, qs1);
            qs1 = MFMA32(*(const LAS bf16x8*)(A + DNP_AF + 3 * 1024), vn01, qs1);
            qs1 = MFMA32(*(const LAS bf16x8*)(A + DNP_AF + 4 * 1024), vn10, qs1);
            qs1 = MFMA32(*(const LAS bf16x8*)(A + DNP_AF + 5 * 1024), vn11, qs1);
#pragma unroll
            for (int db = 0; db < 4; ++db) {
#pragma unroll
                for (int r = 0; r < 16; ++r) St[db][r] *= egl;
                St[db] = MFMA32(*(const LAS bf16x8*)(A + DNP_KF + ((db * 2 + 0) * 2 + 0) * 1024), vn00, St[db]);
                St[db] = MFMA32(*(const LAS bf16x8*)(A + DNP_KF + ((db * 2 + 0) * 2 + 1) * 1024), vn01, St[db]);
                St[db] = MFMA32(*(const LAS bf16x8*)(A + DNP_KF + ((db * 2 + 1) * 2 + 0) * 1024), vn10, St[db]);
                St[db] = MFMA32(*(const LAS bf16x8*)(A + DNP_KF + ((db * 2 + 1) * 2 + 1) * 1024), vn11, St[db]);
                Sb[db][0] = PACK8(St[db], 0); Sb[db][1] = PACK8(St[db], 1);
            }
            LAS float* Os = (LAS float*)(L + SL_O) + 32 * w + (lane & 31);
#pragma unroll
            for (int r = 0; r < 16; ++r) { Os[crow(r, hi) * 128] = qs0[r]; Os[(32 + crow(r, hi)) * 128] = qs1[r]; }
            __syncthreads();
            scan_norm_rows(L + SL_O, gain, zy0 + (size_t)(64 * n) * 2048, w, lane);
            __syncthreads();
        }
    } else {
        const int lt = tid - 256;
        u32x4 st[14];
#pragma unroll
        for (int k = 0; k < 14; ++k) st[k] = *(const GAS u32x4*)(dnp_bh + (size_t)(lt + 256 * k) * 16);
#pragma unroll
        for (int k = 0; k < 14; ++k) *(LAS u32x4*)(L + SL_A + (lt + 256 * k) * 16) = st[k];
#pragma unroll
        for (int k = 0; k < 14; ++k) st[k] = *(const GAS u32x4*)(dnp_bh + DNP_UNIT + (size_t)(lt + 256 * k) * 16);
        __syncthreads();
#pragma unroll 1
        for (int n = 0; n < 32; ++n) {
            __syncthreads();
            if (n + 1 < 32) {
#pragma unroll
                for (int k = 0; k < 14; ++k) *(LAS u32x4*)(L + SL_A + (lt + 256 * k) * 16) = st[k];
                if (n + 2 < 32) { const unsigned char* nb = dnp_bh + (size_t)(n + 2) * DNP_UNIT;
#pragma unroll
                    for (int k = 0; k < 14; ++k) st[k] = *(const GAS u32x4*)(nb + (size_t)(lt + 256 * k) * 16); }
            }
            scan_norm_rows(L + SL_O, gain, zy0 + (size_t)(64 * n) * 2048, w, lane);
            __syncthreads();
        }
    }
}

constexpr int GP1_UNIT = 25600, GP1_QF = 0, GP1_OL = 8192, GP1_EB = 24576, GP2_UNIT = 16384;
constexpr int GL_B = 0, GL_QK = 16384, GL_KD = 32768, GL_V = 49152, GL_TOT = 65536, GL_BL = 67584;

__device__ __forceinline__ void gla_pre_unit(const Frame& F, const bf16* GLQ, const float* SM, const float* w2, const float* gb, unsigned char* gp1, unsigned char* gp2, int bl, int h, int n) {
    int tid_ = F.tid; asm volatile("" : "+v"(tid_));
    const int tid = tid_, lane = tid & 63, w = __builtin_amdgcn_readfirstlane(tid >> 6), r32 = lane & 31, hi = lane >> 5;
    LAS unsigned char* L = F.lds;
    LAS float* tot = (LAS float*)(L + GL_TOT);
    {
        const int i = tid >> 3, dg = tid & 7, row = bl * SEQ + 64 * n + i;
        float v[8];
        { const GAS f32x4* gp = (const GAS f32x4*)(SM + (size_t)row * 32 + 8);
          const f32x4 g0 = gp[0], g1 = gp[1], g2 = gp[2], g3 = gp[3];
          const float gr[16] = {g0.x, g0.y, g0.z, g0.w, g1.x, g1.y, g1.z, g1.w, g2.x, g2.y, g2.z, g2.w, g3.x, g3.y, g3.z, g3.w};
          const GAS f32x4* bp = (const GAS f32x4*)(gb + h * 64 + 8 * dg);
          const f32x4 b0 = bp[0], b1 = bp[1];
          v[0] = b0.x; v[1] = b0.y; v[2] = b0.z; v[3] = b0.w; v[4] = b1.x; v[5] = b1.y; v[6] = b1.z; v[7] = b1.w;
#pragma unroll
          for (int r = 0; r < 16; ++r) { const GAS f32x4* wp = (const GAS f32x4*)(w2 + r * 256 + h * 64 + 8 * dg); const f32x4 w0 = wp[0], w1 = wp[1];
              v[0] += gr[r] * w0.x; v[1] += gr[r] * w0.y; v[2] += gr[r] * w0.z; v[3] += gr[r] * w0.w; v[4] += gr[r] * w1.x; v[5] += gr[r] * w1.y; v[6] += gr[r] * w1.z; v[7] += gr[r] * w1.w; } }
#pragma unroll
        for (int c = 0; c < 8; ++c) v[c] = (fminf(v[c], 0.f) - log1pf(__expf(-fabsf(v[c])))) * (1.f / 16.f);
#pragma unroll
        for (int o = 8; o < 64; o <<= 1) {
#pragma unroll
            for (int c = 0; c < 8; ++c) { const float tt = __builtin_bit_cast(float, __builtin_amdgcn_ds_bpermute(((lane - o) & 63) << 2, __builtin_bit_cast(int, v[c]))); if (lane >= o) v[c] += tt; } }
        if (lane >= 56) {
#pragma unroll
            for (int c = 0; c < 8; ++c) tot[w * 64 + 8 * dg + c] = v[c]; }
        __syncthreads();
        float bl_[8];
#pragma unroll
        for (int c = 0; c < 8; ++c) { float pre = 0.f, all = 0.f;
#pragma unroll
            for (int ww = 0; ww < 8; ++ww) { const float tv = tot[ww * 64 + 8 * dg + c]; all += tv; if (ww < w) pre += tv; }
            v[c] += pre; bl_[c] = all; }
        if (tid < 8) {
            f32x4 e0, e1; e0.x = __expf(bl_[0]); e0.y = __expf(bl_[1]); e0.z = __expf(bl_[2]); e0.w = __expf(bl_[3]); e1.x = __expf(bl_[4]); e1.y = __expf(bl_[5]); e1.z = __expf(bl_[6]); e1.w = __expf(bl_[7]);
            GAS f32x4* ep = (GAS f32x4*)(gp1 + GP1_EB + 32 * dg); ep[0] = e0; ep[1] = e1; }
        const GAS bf16* gr_ = (const GAS bf16*)(GLQ + (size_t)row * 1024);
        const u32x4 qw = *(const GAS u32x4*)(gr_ + h * 64 + 8 * dg), kw = *(const GAS u32x4*)(gr_ + 256 + h * 64 + 8 * dg);
        const u32x4 v0 = *(const GAS u32x4*)(gr_ + 512 + h * 128 + 16 * dg), v1 = *(const GAS u32x4*)(gr_ + 512 + h * 128 + 16 * dg + 8);
        float qf[8] = {bflo(qw.x), bfhi(qw.x), bflo(qw.y), bfhi(qw.y), bflo(qw.z), bfhi(qw.z), bflo(qw.w), bfhi(qw.w)};
        float kf[8] = {bflo(kw.x), bfhi(kw.x), bflo(kw.y), bfhi(kw.y), bflo(kw.z), bfhi(kw.z), bflo(kw.w), bfhi(kw.w)};
        float qt[8], kh[8], kd[8];
#pragma unroll
        for (int c = 0; c < 8; ++c) { qt[c] = qf[c] * 0.125f * __expf(v[c]); kh[c] = kf[c] * __expf(-v[c]); kd[c] = kf[c] * __expf(bl_[c] - v[c]); }
        *(LAS u32x4*)(L + GL_QK + offb(i, dg)) = (u32x4){cvtpk(qt[0], qt[1]), cvtpk(qt[2], qt[3]), cvtpk(qt[4], qt[5]), cvtpk(qt[6], qt[7])};
        *(LAS u32x4*)(L + GL_QK + offb(i, 8 + dg)) = (u32x4){cvtpk(kh[0], kh[1]), cvtpk(kh[2], kh[3]), cvtpk(kh[4], kh[5]), cvtpk(kh[6], kh[7])};
        *(LAS u32x4*)(L + GL_KD + offb(i, dg)) = (u32x4){cvtpk(kd[0], kd[1]), cvtpk(kd[2], kd[3]), cvtpk(kd[4], kd[5]), cvtpk(kd[6], kd[7])};
        *(LAS u32x4*)(L + GL_V + offb(i, 2 * dg)) = v0; *(LAS u32x4*)(L + GL_V + offb(i, 2 * dg + 1)) = v1;
        __syncthreads();
    }
    const unsigned blk = (lane >> 4) & 1, q_ = (lane & 15) >> 2, p = lane & 3, cofs = 2 * blk + (p >> 1), bo = 8 * (p & 1);
    if (w < 4) {
        const int eb = w;
        f32x16 x00, x01, x11;
#pragma unroll
        for (int r = 0; r < 16; ++r) { x00[r] = 0.f; x01[r] = 0.f; x11[r] = 0.f; }
#pragma unroll
        for (int s = 0; s < 4; ++s) {
            const bf16x8 k0 = *(const LAS bf16x8*)(L + GL_QK + offb(r32, 8 + 2 * s + hi)), k1 = *(const LAS bf16x8*)(L + GL_QK + offb(32 + r32, 8 + 2 * s + hi));
            const bf16x8 q0 = *(const LAS bf16x8*)(L + GL_QK + offb(r32, 2 * s + hi)), q1 = *(const LAS bf16x8*)(L + GL_QK + offb(32 + r32, 2 * s + hi));
            x00 = MFMA32(k0, q0, x00); x01 = MFMA32(k0, q1, x01); x11 = MFMA32(k1, q1, x11);
        }
#pragma unroll
        for (int r = 0; r < 16; ++r) { const int j = crow(r, hi); if (j > r32) { x00[r] = 0.f; x11[r] = 0.f; } }
        f32x16 o0, o1;
#pragma unroll
        for (int r = 0; r < 16; ++r) { o0[r] = 0.f; o1[r] = 0.f; }
#pragma unroll
        for (int jb = 0; jb < 2; ++jb)
#pragma unroll
            for (int s = 0; s < 2; ++s) {
                const int rb = 32 * jb + 16 * s + 4 * hi;
                const s16x4 lo = tr_rd(L + GL_V + offb(rb + q_, 4 * eb + cofs) + bo), hv = tr_rd(L + GL_V + offb(rb + 8 + q_, 4 * eb + cofs) + bo);
                const bf16x8 vf = (bf16x8){lo[0], lo[1], lo[2], lo[3], hv[0], hv[1], hv[2], hv[3]};
                if (jb == 0) { o0 = MFMA32(PACK8(x00, s), vf, o0); o1 = MFMA32(PACK8(x01, s), vf, o1); }
                else o1 = MFMA32(PACK8(x11, s), vf, o1);
            }
        GAS u32x4* op = (GAS u32x4*)(gp1 + GP1_OL + ((eb * 2 + 0) * 64 + lane) * 32);
        op[0] = (u32x4){cvtpk(o0[0], o0[1]), cvtpk(o0[2], o0[3]), cvtpk(o0[4], o0[5]), cvtpk(o0[6], o0[7])}; op[1] = (u32x4){cvtpk(o0[8], o0[9]), cvtpk(o0[10], o0[11]), cvtpk(o0[12], o0[13]), cvtpk(o0[14], o0[15])};
        op[128] = (u32x4){cvtpk(o1[0], o1[1]), cvtpk(o1[2], o1[3]), cvtpk(o1[4], o1[5]), cvtpk(o1[6], o1[7])}; op[129] = (u32x4){cvtpk(o1[8], o1[9]), cvtpk(o1[10], o1[11]), cvtpk(o1[12], o1[13]), cvtpk(o1[14], o1[15])};
    } else {
        const int eb = w - 4;
        f32x16 c0, c1;
#pragma unroll
        for (int r = 0; r < 16; ++r) { c0[r] = 0.f; c1[r] = 0.f; }
#pragma unroll
        for (int s = 0; s < 4; ++s) {
            const int rb = 16 * s + 8 * hi;
            const s16x4 va = tr_rd(L + GL_V + offb(rb + q_, 4 * eb + cofs) + bo), vb2 = tr_rd(L + GL_V + offb(rb + 4 + q_, 4 * eb + cofs) + bo);
            const s16x4 ka = tr_rd(L + GL_KD + offb(rb + q_, cofs) + bo), kb2 = tr_rd(L + GL_KD + offb(rb + 4 + q_, cofs) + bo);
            const s16x4 kc = tr_rd(L + GL_KD + offb(rb + q_, 4 + cofs) + bo), kd2 = tr_rd(L + GL_KD + offb(rb + 4 + q_, 4 + cofs) + bo);
            const bf16x8 vf = (bf16x8){va[0], va[1], va[2], va[3], vb2[0], vb2[1], vb2[2], vb2[3]};
            c0 = MFMA32(((bf16x8){ka[0], ka[1], ka[2], ka[3], kb2[0], kb2[1], kb2[2], kb2[3]}), vf, c0);
            c1 = MFMA32(((bf16x8){kc[0], kc[1], kc[2], kc[3], kd2[0], kd2[1], kd2[2], kd2[3]}), vf, c1);
        }
        GAS u32x4* kp = (GAS u32x4*)(gp2 + ((eb * 2 + 0) * 64 + lane) * 32);
        kp[0] = (u32x4){cvtpk(c0[0], c0[1]), cvtpk(c0[2], c0[3]), cvtpk(c0[4], c0[5]), cvtpk(c0[6], c0[7])}; kp[1] = (u32x4){cvtpk(c0[8], c0[9]), cvtpk(c0[10], c0[11]), cvtpk(c0[12], c0[13]), cvtpk(c0[14], c0[15])};
        kp[128] = (u32x4){cvtpk(c1[0], c1[1]), cvtpk(c1[2], c1[3]), cvtpk(c1[4], c1[5]), cvtpk(c1[6], c1[7])}; kp[129] = (u32x4){cvtpk(c1[8], c1[9]), cvtpk(c1[10], c1[11]), cvtpk(c1[12], c1[13]), cvtpk(c1[14], c1[15])};
#pragma unroll
        for (int x = 0; x < 2; ++x) { const int f = 2 * eb + x, ib = f >> 2, db = (f >> 1) & 1, s = f & 1, i = 32 * ib + r32;
            const unsigned long long lo = *(const LAS unsigned long long*)(L + GL_QK + offb(i, 4 * db + 2 * s) + 8 * hi), hv = *(const LAS unsigned long long*)(L + GL_QK + offb(i, 4 * db + 2 * s + 1) + 8 * hi);
            *(GAS u32x4*)(gp1 + GP1_QF + f * 1024 + lane * 16) = (u32x4){(unsigned)lo, (unsigned)(lo >> 32), (unsigned)hv, (unsigned)(hv >> 32)}; }
    }
    __syncthreads();
}

__device__ __forceinline__ void scan_norm_rows2(LAS unsigned char* Ostage, const float* gain, bf16* zy_chunk, int row0, int lane) {
    const f32x2_t gg = *(const GAS f32x2_t*)(gain + 2 * lane);
#pragma unroll 4
    for (int rr = 0; rr < 16; ++rr) { const int i = row0 + rr;
        const f32x2_t o = *(const LAS f32x2_t*)(Ostage + (i * 128 + 2 * lane) * 4);
        const float rs = rsqrtf(wave_sum(o.x * o.x + o.y * o.y, lane) * (1.f / 128.f) + EPS);
        GAS unsigned* zp = (GAS unsigned*)(zy_chunk + (size_t)i * 2048 + 2 * lane);
        const unsigned zw = *zp;
        *zp = cvtpk(o.x * rs * gg.x * silu_f(bflo(zw)), o.y * rs * gg.y * silu_f(bfhi(zw))); }
}
__device__ __forceinline__ void gla_scan_wg(const Frame& F, const unsigned char* gp1_all, const unsigned char* gp2_all, const float* gain, bf16* ZYh, int c0) {
    const int lane = F.lane, w = F.wave, hi = lane >> 5, sub = w >> 2, eb = w & 3;
    const int c = c0 + sub, bl = c >> 2, h = c & 3;
    LAS unsigned char* Ost = F.lds + sub * 32768;
    const unsigned char* g1 = gp1_all + (size_t)c * 32 * GP1_UNIT; const unsigned char* g2 = gp2_all + (size_t)c * 32 * GP2_UNIT;
    bf16* zy0 = ZYh + (size_t)(bl * SEQ) * 2048 + 1536 + h * 128;
    f32x16 St[2]; bf16x8 Sb[2][2];
#pragma unroll
    for (int d = 0; d < 2; ++d) {
#pragma unroll
        for (int r = 0; r < 16; ++r) St[d][r] = 0.f;
        Sb[d][0] = (bf16x8){0, 0, 0, 0, 0, 0, 0, 0}; Sb[d][1] = (bf16x8){0, 0, 0, 0, 0, 0, 0, 0}; }
    bf16x8 qn[8]; u32x4 on[4];
#pragma unroll
    for (int f = 0; f < 8; ++f) qn[f] = *(const GAS bf16x8*)(g1 + GP1_QF + f * 1024 + lane * 16);
    { const GAS u32x4* op = (const GAS u32x4*)(g1 + GP1_OL + ((eb * 2) * 64 + lane) * 32); on[0] = op[0]; on[1] = op[1]; on[2] = op[128]; on[3] = op[129]; }
#pragma unroll 1
    for (int n = 0; n < 32; ++n) {
        const unsigned char* u1 = g1 + (size_t)n * GP1_UNIT; const unsigned char* u2 = g2 + (size_t)n * GP2_UNIT;
        u32x4 kv[4]; f32x4 ebv[2][4];
        { const GAS u32x4* kp = (const GAS u32x4*)(u2 + ((eb * 2) * 64 + lane) * 32); kv[0] = kp[0]; kv[1] = kp[1]; kv[2] = kp[128]; kv[3] = kp[129]; }
#pragma unroll
        for (int db = 0; db < 2; ++db)
#pragma unroll
            for (int g = 0; g < 4; ++g) ebv[db][g] = *(const GAS f32x4*)(u1 + GP1_EB + (32 * db + 8 * g + 4 * hi) * 4);
        f32x16 o0, o1;
#pragma unroll
        for (int r = 0; r < 8; ++r) { const unsigned a = (r < 4 ? on[0] : on[1])[r & 3], b = (r < 4 ? on[2] : on[3])[r & 3];
            o0[2 * r] = bflo(a); o0[2 * r + 1] = bfhi(a); o1[2 * r] = bflo(b); o1[2 * r + 1] = bfhi(b); }
#pragma unroll
        for (int db = 0; db < 2; ++db)
#pragma unroll
            for (int s = 0; s < 2; ++s) { o0 = MFMA32(qn[(0 * 2 + db) * 2 + s], Sb[db][s], o0); o1 = MFMA32(qn[(1 * 2 + db) * 2 + s], Sb[db][s], o1); }
        if (n + 1 < 32) {
#pragma unroll
            for (int f = 0; f < 8; ++f) qn[f] = *(const GAS bf16x8*)(u1 + GP1_UNIT + GP1_QF + f * 1024 + lane * 16);
            const GAS u32x4* op = (const GAS u32x4*)(u1 + GP1_UNIT + GP1_OL + ((eb * 2) * 64 + lane) * 32); on[0] = op[0]; on[1] = op[1]; on[2] = op[128]; on[3] = op[129];
        }
#pragma unroll
        for (int db = 0; db < 2; ++db) {
#pragma unroll
            for (int r = 0; r < 8; ++r) { const unsigned kw = (r < 4 ? kv[2 * db] : kv[2 * db + 1])[r & 3];
                St[db][2 * r] = St[db][2 * r] * ebv[db][(2 * r) >> 2][(2 * r) & 3] + bflo(kw); St[db][2 * r + 1] = St[db][2 * r + 1] * ebv[db][(2 * r + 1) >> 2][(2 * r + 1) & 3] + bfhi(kw); }
            Sb[db][0] = PACK8(St[db], 0); Sb[db][1] = PACK8(St[db], 1);
        }
        LAS float* Os = (LAS float*)Ost + 32 * eb + (lane & 31);
#pragma unroll
        for (int r = 0; r < 16; ++r) { Os[crow(r, hi) * 128] = o0[r]; Os[(32 + crow(r, hi)) * 128] = o1[r]; }
        __syncthreads();
        scan_norm_rows2(Ost, gain, zy0 + (size_t)(64 * n) * 2048, 16 * eb, lane);
        __syncthreads();
    }
}
struct Args { const float* in[21]; float* out; unsigned char* ws; };
#define GRID_BAR() do { XcdBarrier b_ = bar; asm volatile("" : "+s"(b_.bar), "+s"(b_.x)); xcd_barrier(b_); } while (0)
template <int l, int hb> __device__ __forceinline__ void half_fn(Frame& F, const XcdBarrier& bar, volatile LAS unsigned* MISC) {
    const CAS unsigned char* kp;
            PHASE_BEGIN();
            { unsigned char* ws = WSP; bf16* ZYh = (bf16*)(ws + WS_ZY) + (size_t)hb * HBROWS * 2048;
              pg8::Gemm g{(bf16*)(ws + WS_H) + (size_t)hb * HBROWS * DM, (bf16*)(ws + WS_WIN), HBROWS, NPROJ, DM}; pg8::StaticOrder S; S.init(HBROWS, NPROJ, F.G, F.bx);
              pg8::EpiProj E{(bf16*)(ws + WS_QKV), ZYh, (bf16*)(ws + WS_DNQ), (bf16*)(ws + WS_GLQ), (float*)(ws + WS_SM), 0.125f * LOG2E};
              pg8::gemm_phase<pg8::EpiProj, pg8::StaticOrder, true, true>(F.lds, g, S, E); }
            GRID_BAR();
            PHASE_BEGIN();
            { unsigned char* ws = WSP; const bf16* DNQ = (const bf16*)(ws + WS_DNQ); const float* SM = (const float*)(ws + WS_SM);
              const float* convw = INP(IN_DNCONV) + (size_t)l * 4 * 1536; const float* w2 = INP(IN_GW2) + (size_t)l * 16 * 256; const float* gb = INP(IN_GB) + l * 256;
              const float* alog = INP(IN_ALOG) + l * 4; const float* dtb = INP(IN_DTB) + l * 4;
              unsigned char* gp1 = ws + (hb == 0 ? 24 : 32) * MiB;
              for (int u = F.bx; u < 512; u += F.G) dn_pre_unit(F, DNQ, SM, convw, alog, dtb, ws + WS_DNP + (size_t)u * DNP_UNIT, u >> 7, (u >> 5) & 3, u & 31);
              for (int u = F.bx; u < 512; u += F.G) gla_pre_unit(F, (const bf16*)(ws + WS_GLQ), SM, w2, gb, gp1 + (size_t)u * GP1_UNIT, ws + WS_GP2 + (size_t)u * GP2_UNIT, u >> 7, (u >> 5) & 3, u & 31);
              if (hb == 1) { const float* pl = INP(IN_P) + (size_t)l * NTOK * 256; bf16* PBF = (bf16*)(ws + WS_PBF);
                  for (int it = F.gw * 64 + F.lane; it < NTOK * 256 / 4; it += F.NGW * 64) { const f32x4 v = ((const GAS f32x4*)pl)[it]; ((GAS unsigned long long*)PBF)[it] = (unsigned long long)pk2(v.x, v.y) | ((unsigned long long)pk2(v.z, v.w) << 32); } } }
            GRID_BAR();
            PHASE_BEGIN();
            { unsigned char* ws = WSP; bf16* ZYh = (bf16*)(ws + WS_ZY) + (size_t)hb * HBROWS * 2048; const float* SM = (const float*)(ws + WS_SM);
              const int w = F.bx;
              if (w < 16) dn_scan_wg(F, ws + WS_DNP + (size_t)w * 32 * DNP_UNIT, INP(IN_DNNORM) + l * 128, ZYh, w >> 2, w & 3);
              else if (w < 24) gla_scan_wg(F, ws + (hb == 0 ? 24 : 32) * MiB, ws + WS_GP2, INP(IN_GNORM) + l * 128, ZYh, 2 * (w - 16));
              { const float la = wave_sum(INP(IN_LQ1)[l * 64 + F.lane] * INP(IN_LK1)[l * 64 + F.lane], F.lane), lb = wave_sum(INP(IN_LQ2)[l * 64 + F.lane] * INP(IN_LK2)[l * 64 + F.lane], F.lane);
                const float lam_init = l == 0 ? 0.2f : 0.35550906f;
                const float lam = __expf(la) - __expf(lb) + lam_init;
                attn_phase(F, (unsigned*)(ws + WS_CTL) + CW_Q + 16 * (l * 2 + hb), MISC, (const bf16*)(ws + WS_QKV), ZYh, INP(IN_SUBLN) + l * 128, lam, lam_init); } }
            GRID_BAR();
}
template <int l> __device__ __forceinline__ void layer_fn(Frame& F, const XcdBarrier& bar, volatile LAS unsigned* MISC) {
    const CAS unsigned char* kp;
        PHASE_BEGIN();
        { unsigned char* ws = WSP;
          convert_weights(F, INP(IN_WIN), INP(IN_WOUT), INP(IN_PGATE), INP(IN_PPROJ), ws, l);
          if (l == 0) { bf16* H = (bf16*)(ws + WS_H); const float* x = INP(IN_X); const float* pre_g = INP(IN_PREG);
              for (int m = F.gw; m < NTOK; m += F.NGW) rms_row_to_bf16(x + (size_t)m * DM, pre_g, H + (size_t)m * DM, F.lane); } }
        GRID_BAR();
        half_fn<l, 0>(F, bar, MISC);
        half_fn<l, 1>(F, bar, MISC);
        PHASE_BEGIN();
        { unsigned char* ws = WSP;
          pg8::Gemm g{(bf16*)(ws + WS_ZY), (bf16*)(ws + WS_WOUT), NTOK, DM, 2048}; pg8::StaticOrder S; S.init(NTOK, DM, F.G, F.bx);
          pg8::EpiF32 E{(float*)(ws + WS_T1), DM};
          pg8::gemm_phase<pg8::EpiF32, pg8::StaticOrder, true, true>(F.lds, g, S, E); }
        PHASE_BEGIN();
        { unsigned char* ws = WSP;
          pg8::Gemm g{(bf16*)(ws + WS_PBF), (bf16*)(ws + WS_WP), NTOK, DM, 256}; pg8::StaticOrder S; S.init(NTOK, DM, F.G, F.bx);
          pg8::EpiBf E{(bf16*)(ws + WS_PP), DM};
          pg8::gemm_phase<pg8::EpiBf, pg8::StaticOrder, true, true>(F.lds, g, S, E); }
        GRID_BAR();
        PHASE_BEGIN();
        { unsigned char* ws = WSP; float* out = OUTP; const float* xin = l == 0 ? INP(IN_X) : (const float*)out; const float* T1 = (const float*)(ws + WS_T1); bf16* XB = (bf16*)(ws + WS_XB); const float* pg = INP(IN_POSTG) + l * DM;
          for (int m = F.gw; m < NTOK; m += F.NGW) norm_res_row(xin + (size_t)m * DM, T1 + (size_t)m * DM, pg, out + (size_t)m * DM, XB + (size_t)m * DM, nullptr, nullptr, F.lane); }
        GRID_BAR();
        PHASE_BEGIN();
        { unsigned char* ws = WSP;
          pg8::Gemm g{(bf16*)(ws + WS_XB), (bf16*)(ws + WS_WG), NTOK, DM, DM}; pg8::StaticOrder S; S.init(NTOK, DM, F.G, F.bx);
          pg8::EpiGate E{(const bf16*)(ws + WS_PP), (float*)(ws + WS_T1), DM};
          pg8::gemm_phase<pg8::EpiGate, pg8::StaticOrder, true, true>(F.lds, g, S, E); }
        GRID_BAR();
        PHASE_BEGIN();
        { unsigned char* ws = WSP; float* out = OUTP; const float* T1 = (const float*)(ws + WS_T1); const float* pn = INP(IN_PNORM) + l * DM;
          if (l == 0) {
            bf16* H = (bf16*)(ws + WS_H); const float* pre1 = INP(IN_PREG) + DM;
            for (int m = F.gw; m < NTOK; m += F.NGW) norm_res_row(out + (size_t)m * DM, T1 + (size_t)m * DM, pn, out + (size_t)m * DM, nullptr, pre1, H + (size_t)m * DM, F.lane);
          } else {
            for (int m = F.gw; m < NTOK; m += F.NGW) norm_res_row(out + (size_t)m * DM, T1 + (size_t)m * DM, pn, out + (size_t)m * DM, nullptr, nullptr, nullptr, F.lane);
          } }
}
__global__ void __launch_bounds__(NTHR, 2) mk_fwd(Args args) {
    extern __shared__ __attribute__((aligned(16))) unsigned char lds[];
    Frame F;
    F.lds = (LAS unsigned char*)lds;
    F.tid = threadIdx.x; F.lane = F.tid & 63; F.wave = __builtin_amdgcn_readfirstlane(F.tid >> 6);
    F.G = gridDim.x; { const int bx = blockIdx.x; F.vcu = (F.G % 8 == 0) ? (bx % 8) * (F.G / 8) + bx / 8 : bx; F.bx = bx; }
    F.gw = F.vcu * NWAVES + F.wave; F.NGW = F.G * NWAVES;
    volatile LAS unsigned* MISC = (volatile LAS unsigned*)(F.lds + MISC_OFF);
    for (int u = F.tid; u < (LDS_BYTES - LDSCTL_OFF) / 4; u += NTHR) ((LAS unsigned*)(F.lds + LDSCTL_OFF))[u] = 0u;
    __syncthreads();
    const XcdBarrier bar = xcd_barrier_post((unsigned*)(args.ws + WS_CTL) + CW_BAR, MISC + 8);
    layer_fn<0>(F, bar, MISC);
    layer_fn<1>(F, bar, MISC);
}

extern "C" void kernel_launch(void* const* d_in, const int* in_sizes, int n_in, void* d_out, int out_size, void* d_ws, size_t ws_size, hipStream_t stream) {
    static int grid = 0;
    if (grid == 0) {
        if (n_in != 21 || out_size != NTOK * DM || ws_size < WS_END) { fprintf(stderr, "kernel_launch: unexpected shapes (n_in %d out %d ws %zu)\n", n_in, out_size, ws_size); grid = -1; return; }
        int dev = 0, cus = 0;
        if (hipGetDevice(&dev) != hipSuccess || hipDeviceGetAttribute(&cus, hipDeviceAttributeMultiprocessorCount, dev) != hipSuccess) { grid = -1; return; }
        if (hipFuncSetAttribute((const void*)mk_fwd, hipFuncAttributeMaxDynamicSharedMemorySize, LDS_BYTES) != hipSuccess) { fprintf(stderr, "kernel_launch: hipFuncSetAttribute failed\n"); grid = -1; return; }
        int per_cu = 0;
        if (hipOccupancyMaxActiveBlocksPerMultiprocessor(&per_cu, (const void*)mk_fwd, NTHR, LDS_BYTES) != hipSuccess || per_cu < 1) fprintf(stderr, "kernel_launch: occupancy query says %d per CU\n", per_cu);
        (void)hipGetLastError();
        grid = cus;
    }
    if (grid < 0) return;
    if (hipMemsetAsync((char*)d_ws + WS_CTL, 0, CTL_ZERO_BYTES, stream) != hipSuccess) return;
    Args a{};
    for (int i = 0; i < 21; ++i) a.in[i] = (const float*)d_in[i];
    a.out = (float*)d_out; a.ws = (unsigned char*)d_ws;
    hipLaunchKernelGGL(mk_fwd, dim3(grid), dim3(NTHR), LDS_BYTES, stream, a);
}
```
